# Optimizing an MI355X kernel written in HIP

```python
import math
import jax, jax.numpy as jnp
from jax import lax
import numpy as np

D_MODEL = 2048
BATCH = 2
SEQ = 4096
DEPTH = 1
DEC_BATCH = 32
DEC_SEQ = 64
PAST_LEN = 2048

CHUNK = 64
H_A = 8
DK_A = 64
DV_A = 2 * DK_A
W_QK_A = H_A * 2 * DK_A
W_A = H_A * DV_A
H_B = 8
DH_B = 128
W_B = H_B * DH_B
N_PREV = 8
BAND = N_PREV + 1
BAND_ROWS = N_PREV * CHUNK
MAX_REL = 128
FFN_DIM = 4 * D_MODEL
ROPE_THETA = 10000.0
EPS = 1e-6
Q_BLOCK = 128
NEG = -1e30

kernel_name = 'hybrid_streaming_encoder_step'


def rms_norm(x, g):
    xf = x.astype(jnp.float32)
    y = xf * lax.rsqrt(jnp.mean(xf * xf, axis=-1, keepdims=True) + EPS)
    return (y * g.astype(jnp.float32)).astype(x.dtype)


def swiglu_ffn(x, g, w_gate, w_up, w_down):
    h = rms_norm(x, g)
    return (jax.nn.silu(h @ w_gate) * (h @ w_up)) @ w_down


def rope(x, pos):
    half = x.shape[-1] // 2
    inv = ROPE_THETA ** (-jnp.arange(half, dtype=jnp.float32) / half)
    ang = pos.astype(jnp.float32)[:, None] * inv[None, :]
    cos = jnp.cos(ang)[:, None, :]
    sin = jnp.sin(ang)[:, None, :]
    x1 = x[..., :half].astype(jnp.float32)
    x2 = x[..., half:].astype(jnp.float32)
    out = jnp.concatenate([x1 * cos - x2 * sin, x2 * cos + x1 * sin], axis=-1)
    return out.astype(x.dtype)


def split_projection(h, w_in, pos):
    b, s, _ = h.shape
    z = h @ w_in
    cuts = [W_QK_A, 2 * W_QK_A, 2 * W_QK_A + W_A, 2 * W_QK_A + W_A + W_B,
            2 * W_QK_A + W_A + 2 * W_B, 2 * W_QK_A + W_A + 3 * W_B,
            2 * W_QK_A + W_A + 3 * W_B + D_MODEL]
    qa, ka, va, qb, kb, vb, ga, gb = jnp.split(z, cuts, axis=-1)
    qa = rope(qa.reshape(b, s, 2 * H_A, DK_A), pos).reshape(b, s, H_A, 2, DK_A)
    ka = rope(ka.reshape(b, s, 2 * H_A, DK_A), pos).reshape(b, s, H_A, 2 * DK_A)
    va = va.reshape(b, s, H_A, DV_A)
    qb = qb.reshape(b, s, H_B, DH_B)
    kb = kb.reshape(b, s, H_B, DH_B)
    vb = vb.reshape(b, s, H_B, DH_B)
    return qa, ka, va, qb, kb, vb, ga, gb


def diff_attn_core(q, k, v, mask, lam):
    k = k.reshape(k.shape[:3] + (2, DK_A))
    s = jnp.einsum('bqhmd,bkhmd->bhmqk', q, k).astype(jnp.float32) * (DK_A ** -0.5)
    if mask is not None:
        s = jnp.where(mask, s, NEG)
    p = jax.nn.softmax(s, axis=-1)
    a = p[:, :, 0] - lam * p[:, :, 1]
    return jnp.einsum('bhqk,bkhd->bqhd', a.astype(v.dtype), v)


def diff_attn_prompt(q, k, v, lam):
    b, s = q.shape[:2]
    nb = s // Q_BLOCK
    qb = q.reshape(b, nb, Q_BLOCK, H_A, 2, DK_A).swapaxes(0, 1)
    key_chunk = jnp.arange(s) // CHUNK

    def block(args):
        qi, i = args
        q_chunk = (i * Q_BLOCK + jnp.arange(Q_BLOCK)) // CHUNK
        mask = key_chunk[None, :] <= q_chunk[:, None]
        return diff_attn_core(qi, k, v, mask, lam)

    o = lax.map(block, (qb, jnp.arange(nb)))
    return o.swapaxes(0, 1).reshape(b, s, H_A, DV_A)


def rel_bias_lookup(table, q_pos, k_pos):
    rel = jnp.clip(q_pos[:, None] - k_pos[None, :], -MAX_REL, MAX_REL) + MAX_REL
    return table[:, rel].astype(jnp.float32)


def band_attn_prompt(q, k, v, table):
    b, s = q.shape[:2]
    nc = s // CHUNK
    pad = jnp.zeros((b, N_PREV, CHUNK, H_B, DH_B), k.dtype)
    kp = jnp.concatenate([pad, k.reshape(b, nc, CHUNK, H_B, DH_B)], axis=1)
    vp = jnp.concatenate([pad, v.reshape(b, nc, CHUNK, H_B, DH_B)], axis=1)
    idx = jnp.arange(nc)[:, None] + jnp.arange(BAND)[None, :]
    kband = kp[:, idx].reshape(b, nc, BAND * CHUNK, H_B, DH_B)
    vband = vp[:, idx].reshape(b, nc, BAND * CHUNK, H_B, DH_B)
    valid = jnp.repeat(idx >= N_PREV, CHUNK, axis=1)
    bias = rel_bias_lookup(table, BAND_ROWS + jnp.arange(CHUNK), jnp.arange(BAND * CHUNK))
    qc = q.reshape(b, nc, CHUNK, H_B, DH_B)
    sc = jnp.einsum('bcqhd,bckhd->bchqk', qc, kband).astype(jnp.float32) * (DH_B ** -0.5)
    sc = jnp.where(valid[None, :, None, None, :], sc + bias[None, None], NEG)
    p = jax.nn.softmax(sc, axis=-1)
    o = jnp.einsum('bchqk,bckhd->bcqhd', p.astype(v.dtype), vband)
    return o.reshape(b, s, H_B, DH_B)


def band_attn_sample(q, k_all, v_all, table, past_rows):
    dec = q.shape[1]
    bias = rel_bias_lookup(table, past_rows + jnp.arange(dec), jnp.arange(past_rows + dec))
    sc = jnp.einsum('bqhd,bkhd->bhqk', q, k_all).astype(jnp.float32) * (DH_B ** -0.5)
    p = jax.nn.softmax(sc + bias[None], axis=-1)
    return jnp.einsum('bhqk,bkhd->bqhd', p.astype(v_all.dtype), v_all)


def merge_branches(oa, ob, ga, gb, lam_init, subln, w_branch_a, w_branch_b, w_out):
    b, s = oa.shape[:2]
    oa = (rms_norm(oa, subln) * (1.0 - lam_init)).reshape(b, s, W_A)
    ob = ob.reshape(b, s, W_B)
    merged = jax.nn.sigmoid(ga) * (oa @ w_branch_a) + jax.nn.sigmoid(gb) * (ob @ w_branch_b)
    return merged @ w_out


def setup_inputs(seed: int = 0) -> dict:
    key = jax.random.key(seed)
    ks = jax.random.split(key, 26)
    f32 = jnp.float32

    def w(k, shape, fan_in):
        return jax.random.normal(k, shape, f32) * (fan_in ** -0.5)

    def gain(k, shape):
        return 1.0 + 0.01 * jax.random.normal(k, shape, f32)

    band_cache = min(BAND_ROWS, PAST_LEN)
    in_cols = 2 * W_QK_A + W_A + 3 * W_B + 2 * D_MODEL
    return {
        'x_prompt': jax.random.normal(ks[0], (BATCH, SEQ, D_MODEL), f32),
        'x_sample': jax.random.normal(ks[1], (DEC_BATCH, DEC_SEQ, D_MODEL), f32),
        'cache_a_k': jax.random.normal(ks[2], (DEPTH, DEC_BATCH, PAST_LEN, H_A, 2 * DK_A), f32),
        'cache_a_v': jax.random.normal(ks[3], (DEPTH, DEC_BATCH, PAST_LEN, H_A, DV_A), f32),
        'cache_b_k': jax.random.normal(ks[4], (DEPTH, DEC_BATCH, band_cache, H_B, DH_B), f32),
        'cache_b_v': jax.random.normal(ks[5], (DEPTH, DEC_BATCH, band_cache, H_B, DH_B), f32),
        'ffn1_norm': gain(ks[6], (DEPTH, D_MODEL)),
        'ffn1_w_gate': w(ks[7], (DEPTH, D_MODEL, FFN_DIM), D_MODEL),
        'ffn1_w_up': w(ks[8], (DEPTH, D_MODEL, FFN_DIM), D_MODEL),
        'ffn1_w_down': w(ks[9], (DEPTH, FFN_DIM, D_MODEL), FFN_DIM),
        'mix_norm': gain(ks[10], (DEPTH, D_MODEL)),
        'w_in': w(ks[11], (DEPTH, D_MODEL, in_cols), D_MODEL),
        'lambda_q1': 0.1 * jax.random.normal(ks[12], (DEPTH, DK_A), f32),
        'lambda_k1': 0.1 * jax.random.normal(ks[13], (DEPTH, DK_A), f32),
        'lambda_q2': 0.1 * jax.random.normal(ks[14], (DEPTH, DK_A), f32),
        'lambda_k2': 0.1 * jax.random.normal(ks[15], (DEPTH, DK_A), f32),
        'subln_a': gain(ks[16], (DEPTH, DV_A)),
        'rel_bias_b': 0.2 * jax.random.normal(ks[17], (DEPTH, H_B, 2 * MAX_REL + 1), f32),
        'w_branch_a': w(ks[18], (DEPTH, W_A, D_MODEL), W_A),
        'w_branch_b': w(ks[19], (DEPTH, W_B, D_MODEL), W_B),
        'w_out': w(ks[20], (DEPTH, D_MODEL, D_MODEL), D_MODEL),
        'ffn2_norm': gain(ks[21], (DEPTH, D_MODEL)),
        'ffn2_w_gate': w(ks[22], (DEPTH, D_MODEL, FFN_DIM), D_MODEL),
        'ffn2_w_up': w(ks[23], (DEPTH, D_MODEL, FFN_DIM), D_MODEL),
        'ffn2_w_down': w(ks[24], (DEPTH, FFN_DIM, D_MODEL), FFN_DIM),
        'final_norm': gain(ks[25], (D_MODEL,)),
    }


def reference(x_prompt, x_sample, cache_a_k, cache_a_v, cache_b_k, cache_b_v,
              ffn1_norm, ffn1_w_gate, ffn1_w_up, ffn1_w_down,
              mix_norm, w_in, lambda_q1, lambda_k1, lambda_q2, lambda_k2, subln_a,
              rel_bias_b, w_branch_a, w_branch_b, w_out,
              ffn2_norm, ffn2_w_gate, ffn2_w_up, ffn2_w_down, final_norm):
    seq = x_prompt.shape[1]
    dec_seq = x_sample.shape[1]
    past_a = cache_a_k.shape[2]
    past_b = cache_b_k.shape[2]
    prompt_band_rows = min(BAND_ROWS, seq)
    pos_prompt = jnp.arange(seq)
    pos_sample = past_a + jnp.arange(dec_seq)
    f32 = jnp.float32

    xp, xs = x_prompt, x_sample
    ak_p, av_p, bk_p, bv_p = [], [], [], []
    ak_s, av_s, bk_s, bv_s = [], [], [], []
    for layer in range(DEPTH):
        lam_init = 0.8 - 0.6 * math.exp(-0.3 * layer)
        lam = (jnp.exp(jnp.sum(lambda_q1[layer].astype(f32) * lambda_k1[layer].astype(f32)))
               - jnp.exp(jnp.sum(lambda_q2[layer].astype(f32) * lambda_k2[layer].astype(f32)))
               + lam_init)
        ffn1 = (ffn1_norm[layer], ffn1_w_gate[layer], ffn1_w_up[layer], ffn1_w_down[layer])
        ffn2 = (ffn2_norm[layer], ffn2_w_gate[layer], ffn2_w_up[layer], ffn2_w_down[layer])
        merge_w = (subln_a[layer], w_branch_a[layer], w_branch_b[layer], w_out[layer])

        xp = xp + 0.5 * swiglu_ffn(xp, *ffn1)
        qa, ka, va, qb, kb, vb, ga, gb = split_projection(rms_norm(xp, mix_norm[layer]), w_in[layer], pos_prompt)
        oa = diff_attn_prompt(qa, ka, va, lam)
        ob = band_attn_prompt(qb, kb, vb, rel_bias_b[layer])
        xp = xp + merge_branches(oa, ob, ga, gb, lam_init, *merge_w)
        xp = xp + 0.5 * swiglu_ffn(xp, *ffn2)
        ak_p.append(ka)
        av_p.append(va)
        bk_p.append(kb[:, seq - prompt_band_rows:])
        bv_p.append(vb[:, seq - prompt_band_rows:])

        xs = xs + 0.5 * swiglu_ffn(xs, *ffn1)
        qa, ka, va, qb, kb, vb, ga, gb = split_projection(rms_norm(xs, mix_norm[layer]), w_in[layer], pos_sample)
        ka_all = jnp.concatenate([cache_a_k[layer], ka], axis=1)
        va_all = jnp.concatenate([cache_a_v[layer], va], axis=1)
        oa = diff_attn_core(qa, ka_all, va_all, None, lam)
        kb_all = jnp.concatenate([cache_b_k[layer], kb], axis=1)
        vb_all = jnp.concatenate([cache_b_v[layer], vb], axis=1)
        ob = band_attn_sample(qb, kb_all, vb_all, rel_bias_b[layer], past_b)
        xs = xs + merge_branches(oa, ob, ga, gb, lam_init, *merge_w)
        xs = xs + 0.5 * swiglu_ffn(xs, *ffn2)
        ak_s.append(ka)
        av_s.append(va)
        bk_s.append(kb_all[:, dec_seq:])
        bv_s.append(vb_all[:, dec_seq:])

    y_prompt = rms_norm(xp, final_norm)
    y_sample = rms_norm(xs, final_norm)
    return (y_prompt, y_sample,
            jnp.stack(ak_p), jnp.stack(av_p), jnp.stack(bk_p), jnp.stack(bv_p),
            jnp.stack(ak_s), jnp.stack(av_s), jnp.stack(bk_s), jnp.stack(bv_s))
```

```cpp
#include <hip/hip_runtime.h>
#include <cstdio>
#include <cstdint>
#include <type_traits>
namespace pg8 {
#define PG8_LAS __attribute__((address_space(3)))
typedef unsigned short bf16_t;
typedef short bf16x8 __attribute__((ext_vector_type(8)));
typedef float f32x4 __attribute__((ext_vector_type(4)));
typedef unsigned u32x4 __attribute__((ext_vector_type(4)));
constexpr int BM = 256, BK = 64, HALF = 128, HTB = HALF * BK * 2  , STAGE_BYTES = 8 * HTB, NXCD = 8, WGM = 8;

__host__ __device__ __forceinline__ int lds_byte(int r, int c) { const int st = (r >> 4) * 2 + (c >> 5), rr = r & 15, cc = c & 31, ob = rr * 64 + cc * 2; return st * 1024 + (ob ^ (((ob >> 9) & 1) << 5)); }
__host__ __device__ __forceinline__ void stage_rc(int b, int& R, int& C) { const int st = b / 1024, sb = b % 1024, swz = sb ^ (((sb >> 9) & 1) << 5); R = (st >> 1) * 16 + swz / 64; C = (st & 1) * 32 + (swz % 64) / 2; }
__host__ __device__ __forceinline__ int perm32(int rho) { const int n = rho >> 4, i = rho & 15; return 8 * (i >> 2) + 4 * n + (i & 3); }

struct Unit { int pm, pn; };
struct Gemm { const bf16_t* A; const bf16_t* Bt; int M, N, K; };

struct StaticOrder {
    int nM, nN, nwg, G, c;
    __host__ __device__ void init(int M, int N, int G_, int c_) { nM = M / BM; nN = N / BM; nwg = nM * nN; G = G_; c = c_; }
    __host__ __device__ bool next(int i, Unit& u) const {
        const long L = (long)i * G + c; if (L >= nwg) return false;
        int wgid = (int)L; { const int q = nwg / NXCD, r = nwg % NXCD, xcd = wgid % NXCD, off = wgid / NXCD; wgid = (xcd < r ? xcd * (q + 1) : r * (q + 1) + (xcd - r) * q) + off; }
        const int nig = WGM * nN, gid = wgid / nig, fm = gid * WGM, gsz = (nM - fm) < WGM ? (nM - fm) : WGM;
        u.pm = fm + ((wgid % nig) % gsz); u.pn = (wgid % nig) / gsz; return true;
    }
    __device__ __forceinline__ void a_ready(const Unit&) const {}
    __device__ __forceinline__ void done(const Unit&) const {}
};

__device__ __forceinline__ unsigned cvt_pk_bf16(float lo, float hi) { unsigned r; asm volatile("v_cvt_pk_bf16_f32 %0, %1, %2" : "=v"(r) : "v"(lo), "v"(hi)); return r; }
typedef float f32x2 __attribute__((ext_vector_type(2)));
template <class Epi, class Sched, bool ALIGN_EPI = false, bool SP2 = false>
__device__ __forceinline__ void gemm_phase(PG8_LAS unsigned char* lds, const Gemm g, const Sched& S, const Epi& E) {
    const int tid = threadIdx.x, wid = __builtin_amdgcn_readfirstlane(tid >> 6), lane = tid & 63, wr = wid >> 2, wc = wid & 3, fr = lane & 15, fq = lane >> 4;
    const int K = g.K, nt = K / BK;
    unsigned voffA[2], voffB[2];
#pragma unroll
    for (int i = 0; i < 2; ++i) { int R, C; stage_rc(tid * 16 + i * 8192, R, C); const int Rb = Epi::PERM ? ((R & ~31) + perm32(R & 31)) : R;
        voffA[i] = (unsigned)(R * K + C) * 2u; voffB[i] = (unsigned)(Rb * K + C) * 2u; }
    const size_t kstep = (size_t)(BK * 2);
    const size_t hstep = (size_t)HALF * K * 2;
    const size_t tstep = 2 * hstep;
    const unsigned ldsw = (unsigned)wid * 1024u;
    const int aoff = lds_byte(wr * 64 + fr, fq * 8), boff = lds_byte(wc * 32 + fr, fq * 8);
#define PG8_SA(b, h) (((b) * 2 + (h)) * HTB)
#define PG8_SB(b, h) ((4 + (b) * 2 + (h)) * HTB)
#define PG8_STAGE(bufoff, gbase, voff) do { _Pragma("unroll") for (int _i = 0; _i < 2; ++_i) \
        __builtin_amdgcn_global_load_lds((const unsigned*)((const char*)(gbase) + (voff)[_i]), (PG8_LAS unsigned*)(lds + (bufoff) + ldsw + _i * 8192), 16, 0, 0); } while (0)
#define PG8_LDA(dst, b, h) do { _Pragma("unroll") for (int m = 0; m < 4; ++m) _Pragma("unroll") for (int k = 0; k < 2; ++k) dst[m][k] = *(const PG8_LAS bf16x8*)(lds + PG8_SA(b, h) + aoff + m * 2048 + k * 1024); } while (0)
#define PG8_LDB(dst, b, h) do { _Pragma("unroll") for (int n = 0; n < 2; ++n) _Pragma("unroll") for (int k = 0; k < 2; ++k) dst[n][k] = *(const PG8_LAS bf16x8*)(lds + PG8_SB(b, h) + boff + n * 2048 + k * 1024); } while (0)
#define PG8_MMA(ai, bj, At, Bt) do { __builtin_amdgcn_s_setprio(1); _Pragma("unroll") for (int m = 0; m < 4; ++m) _Pragma("unroll") for (int n = 0; n < 2; ++n) _Pragma("unroll") for (int k = 0; k < 2; ++k) \
        acc[ai][bj][m][n] = __builtin_amdgcn_mfma_f32_16x16x32_bf16(Bt[n][k], At[m][k], acc[ai][bj][m][n], 0, 0, 0); __builtin_amdgcn_s_setprio(0); } while (0)
#define PG8_WAIT_V(n) asm volatile("s_waitcnt vmcnt(" #n ")" ::: "memory")
#define PG8_WAIT_L(n) asm volatile("s_waitcnt lgkmcnt(" #n ")" ::: "memory")
#define PG8_BAR __builtin_amdgcn_s_barrier()
#define PG8_SCHED __builtin_amdgcn_sched_barrier(0)
    Unit cur, nxt; int ui = 0;
    if (!S.next(0, cur)) return;
    f32x4 acc[2][2][4][2];
#pragma unroll
    for (int a = 0; a < 2; ++a)
#pragma unroll
        for (int b = 0; b < 2; ++b)
#pragma unroll
            for (int m = 0; m < 4; ++m)
#pragma unroll
                for (int n = 0; n < 2; ++n) acc[a][b][m][n] = (f32x4){0.f, 0.f, 0.f, 0.f};
    bf16x8 At[4][2], B0[2][2], B1[2][2];
    const char* cA = (const char*)g.A + (size_t)cur.pm * tstep; const char* cB = (const char*)g.Bt + (size_t)cur.pn * tstep;
    S.a_ready(cur);
    if constexpr (SP2) {
        PG8_STAGE(PG8_SB(0, 0), cB, voffB); PG8_STAGE(PG8_SB(0, 1), cB + hstep, voffB); PG8_STAGE(PG8_SA(0, 0), cA, voffA); PG8_STAGE(PG8_SA(0, 1), cA + hstep, voffA);
        if (wr == 1) PG8_BAR;
        PG8_WAIT_V(2); PG8_BAR;
        PG8_STAGE(PG8_SB(1, 0), cB + kstep, voffB); PG8_STAGE(PG8_SA(1, 0), cA + kstep, voffA); PG8_STAGE(PG8_SB(1, 1), cB + hstep + kstep, voffB);
        PG8_WAIT_V(6); PG8_BAR;
    } else {
        PG8_STAGE(PG8_SB(0, 0), cB, voffB); PG8_STAGE(PG8_SA(0, 0), cA, voffA); PG8_STAGE(PG8_SB(0, 1), cB + hstep, voffB); PG8_STAGE(PG8_SA(0, 1), cA + hstep, voffA);
        if (wr == 1) PG8_BAR;
        PG8_WAIT_V(4); PG8_BAR;
        PG8_STAGE(PG8_SB(1, 0), cB + kstep, voffB); PG8_STAGE(PG8_SA(1, 0), cA + kstep, voffA); PG8_STAGE(PG8_SB(1, 1), cB + hstep + kstep, voffB);
        PG8_WAIT_V(6); PG8_BAR;
    }
    for (;;) {
        const bool has_next = S.next(ui + 1, nxt);
        const char* nA = has_next ? (const char*)g.A + (size_t)nxt.pm * tstep : cA; const char* nB = has_next ? (const char*)g.Bt + (size_t)nxt.pn * tstep : cB;
        for (int t = 0; t < nt; t += 2) {
            if constexpr (Epi::HAS_MID) { if (t == (nt >> 1)) E.mid(acc, cur, wr, wc, fr, fq); }
            const bool last = (t == nt - 2);
            const char* a1 = cA + (size_t)(t + 1) * kstep;
            const char* a2 = last ? nA : cA + (size_t)(t + 2) * kstep; const char* b2 = last ? nB : cB + (size_t)(t + 2) * kstep;
            const char* a3 = a2 + kstep; const char* b3 = b2 + kstep;
            if (last && has_next) S.a_ready(nxt);
            if constexpr (SP2) {
            PG8_LDB(B0, 0, 0); PG8_LDB(B1, 0, 1); PG8_SCHED; PG8_LDA(At, 0, 0); PG8_STAGE(PG8_SA(1, 1), a1 + hstep, voffA);
            PG8_WAIT_V(8); PG8_WAIT_L(0); PG8_BAR; PG8_MMA(0, 0, At, B0); PG8_MMA(0, 1, At, B1); PG8_BAR; PG8_SCHED;
            PG8_LDA(At, 0, 1); PG8_STAGE(PG8_SB(0, 0), b2, voffB); PG8_STAGE(PG8_SB(0, 1), b2 + hstep, voffB); PG8_STAGE(PG8_SA(0, 0), a2, voffA);
            PG8_WAIT_V(8); PG8_WAIT_L(0); PG8_BAR; PG8_MMA(1, 0, At, B0); PG8_MMA(1, 1, At, B1); PG8_BAR; PG8_SCHED;
            PG8_LDB(B0, 1, 0); PG8_LDB(B1, 1, 1); PG8_SCHED; PG8_LDA(At, 1, 0); PG8_STAGE(PG8_SA(0, 1), a2 + hstep, voffA);
            PG8_WAIT_V(8); PG8_WAIT_L(0); PG8_BAR; PG8_MMA(0, 0, At, B0); PG8_MMA(0, 1, At, B1); PG8_BAR; PG8_SCHED;
            PG8_LDA(At, 1, 1); PG8_STAGE(PG8_SB(1, 0), b3, voffB); PG8_STAGE(PG8_SB(1, 1), b3 + hstep, voffB); PG8_STAGE(PG8_SA(1, 0), a3, voffA);
            PG8_WAIT_V(8); PG8_WAIT_L(0); PG8_BAR; PG8_MMA(1, 0, At, B0); PG8_MMA(1, 1, At, B1); PG8_BAR; PG8_SCHED;
            } else {
            PG8_LDB(B0, 0, 0); PG8_SCHED; PG8_LDA(At, 0, 0); PG8_STAGE(PG8_SA(1, 1), a1 + hstep, voffA);
            PG8_WAIT_L(8); PG8_BAR; PG8_WAIT_L(0); PG8_MMA(0, 0, At, B0); PG8_BAR; PG8_SCHED;
            PG8_LDB(B1, 0, 1); PG8_STAGE(PG8_SB(0, 0), b2, voffB);
            PG8_BAR; PG8_WAIT_L(0); PG8_MMA(0, 1, At, B1); PG8_BAR;
            PG8_LDA(At, 0, 1); PG8_STAGE(PG8_SA(0, 0), a2, voffA);
            PG8_BAR; PG8_WAIT_L(0); PG8_MMA(1, 0, At, B0); PG8_BAR; PG8_SCHED;
            PG8_STAGE(PG8_SB(0, 1), b2 + hstep, voffB);
            PG8_WAIT_V(6); PG8_BAR; PG8_MMA(1, 1, At, B1); PG8_BAR;
            PG8_LDB(B0, 1, 0); PG8_SCHED; PG8_LDA(At, 1, 0); PG8_STAGE(PG8_SA(0, 1), a2 + hstep, voffA);
            PG8_WAIT_L(8); PG8_BAR; PG8_WAIT_L(0); PG8_MMA(0, 0, At, B0); PG8_BAR; PG8_SCHED;
            PG8_LDB(B1, 1, 1); PG8_STAGE(PG8_SB(1, 0), b3, voffB);
            PG8_BAR; PG8_WAIT_L(0); PG8_MMA(0, 1, At, B1); PG8_BAR;
            PG8_LDA(At, 1, 1); PG8_STAGE(PG8_SA(1, 0), a3, voffA);
            PG8_BAR; PG8_WAIT_L(0); PG8_MMA(1, 0, At, B0); PG8_BAR; PG8_SCHED;
            PG8_STAGE(PG8_SB(1, 1), b3 + hstep, voffB);
            PG8_WAIT_V(6); PG8_BAR; PG8_MMA(1, 1, At, B1); PG8_BAR;
            }
        }
        if constexpr (ALIGN_EPI) { if (wr == 0) PG8_BAR; }
        if constexpr (!Epi::AFTER_DRAIN) { E(acc, cur, wr, wc, fr, fq); S.done(cur); }
        if (!has_next) break;
#pragma unroll
        for (int a = 0; a < 2; ++a)
#pragma unroll
            for (int b = 0; b < 2; ++b)
#pragma unroll
                for (int m = 0; m < 4; ++m)
#pragma unroll
                    for (int n = 0; n < 2; ++n) acc[a][b][m][n] = (f32x4){0.f, 0.f, 0.f, 0.f};
        cur = nxt; cA = nA; cB = nB; ++ui;
        if constexpr (ALIGN_EPI) { if (wr == 1) PG8_BAR; }
    }
    PG8_WAIT_V(0);
    if constexpr (!ALIGN_EPI) { if (wr == 0) PG8_BAR; }
    PG8_BAR;
    if constexpr (Epi::AFTER_DRAIN) { E.fused(acc, cur, wr, wc, fr, fq, lds, wid, lane); S.done(cur); }
#undef PG8_SA
#undef PG8_SB
#undef PG8_STAGE
#undef PG8_LDA
#undef PG8_LDB
#undef PG8_MMA
#undef PG8_WAIT_V
#undef PG8_WAIT_L
#undef PG8_BAR
#undef PG8_SCHED
}
}
#define GAS __attribute__((address_space(1)))
#define LAS __attribute__((address_space(3)))
typedef unsigned short bf16;
typedef unsigned v4u __attribute__((ext_vector_type(4)));
typedef float f32x4 __attribute__((ext_vector_type(4)));
typedef short bf16x8 __attribute__((ext_vector_type(8)));
typedef GAS unsigned gu32;
typedef GAS unsigned long long gu64;
#define RLX_AGENT __ATOMIC_RELAXED, __HIP_MEMORY_SCOPE_AGENT
#define LDS_WAIT() asm volatile("s_waitcnt lgkmcnt(0)" ::: "memory")
#define VM_WAIT() asm volatile("s_waitcnt vmcnt(0)" ::: "memory")
__device__ __forceinline__ unsigned long long rt() { return __builtin_amdgcn_s_memrealtime(); }
__device__ __forceinline__ unsigned f2bf(float f) { unsigned u = __builtin_bit_cast(unsigned, f); return (u + 0x7fffu + ((u >> 16) & 1u)) >> 16; }
__device__ __forceinline__ unsigned pk2(float lo, float hi) { return f2bf(lo) | (f2bf(hi) << 16); }

#define XB_TMO      128
#define XB_XCNT(j)  (256  + 64 * (j))
#define XB_XSUB(j)  (1280 + 64 * (j))
#define XB_XGEN(j)  (2304 + 64 * (j))
#define XB_TOP      3328
#define XB_TOPGEN   3392
#define XCD_BAR_WORDS 3456
#define XB_SPIN_CAP (1u << 18)

__device__ __forceinline__ unsigned xb_ld(unsigned* p)              { return __hip_atomic_load(p, __ATOMIC_RELAXED, __HIP_MEMORY_SCOPE_AGENT); }
__device__ __forceinline__ unsigned xb_add(unsigned* p, unsigned v) { return __hip_atomic_fetch_add(p, v, __ATOMIC_RELAXED, __HIP_MEMORY_SCOPE_AGENT); }
__device__ __forceinline__ unsigned xb_xcc_id() { return (unsigned)__builtin_amdgcn_s_getreg((3 << 11) | 20) & 0xFu; }
#define XB_SPIN(cond, bar) do { unsigned _sp = 0; while (cond) { __builtin_amdgcn_s_sleep(1); \
    if ((++_sp & 255u) == 0u) { if (xb_ld(&(bar)[XB_TMO])) break; if (_sp > XB_SPIN_CAP) { atomicAdd(&(bar)[XB_TMO], 1u); break; } } } } while (0)

struct XcdBarrier {
    unsigned* bar; unsigned x;
    volatile LAS unsigned* st;
};

__device__ __forceinline__ XcdBarrier xcd_barrier_post(unsigned* bar, volatile LAS unsigned* st) {
    XcdBarrier b; b.bar = bar; b.x = xb_xcc_id(); b.st = st;
    if (threadIdx.x == 0) (void)xb_add(&bar[XB_XCNT(b.x)], 1u);
    return b;
}
__device__ __forceinline__ void xcd_barrier_complete(unsigned* bar, unsigned x, unsigned& nloc, unsigned& nx) {
    const unsigned G = gridDim.x * gridDim.y * gridDim.z;
    unsigned sum, cnt, mine, sp = 0u;
    for (;;) {
        sum = 0u; cnt = 0u; mine = 0u;
#pragma unroll
        for (unsigned j = 0; j < 16; ++j) { const unsigned c = xb_ld(&bar[XB_XCNT(j)]); sum += c; cnt += (c > 0u) ? 1u : 0u; mine = (j == x) ? c : mine; }
        if (sum == G) break;
        __builtin_amdgcn_s_sleep(1);
        if ((++sp & 255u) == 0u) { if (xb_ld(&bar[XB_TMO])) break; if (sp > XB_SPIN_CAP) { atomicAdd(&bar[XB_TMO], 1u); break; } }
    }
    nloc = mine > 0u ? mine : 1u; nx = cnt > 0u ? cnt : 1u;
}

__device__ __forceinline__ void xcd_barrier(const XcdBarrier& b) {
    asm volatile("s_waitcnt vmcnt(0)" ::: "memory");
    __syncthreads();
    if (threadIdx.x == 0) {
        unsigned* bar = b.bar;
        __builtin_amdgcn_s_waitcnt(0);
        unsigned nloc = b.st[0], nx = b.st[1];
        if (nloc == 0u) { xcd_barrier_complete(bar, b.x, nloc, nx); b.st[0] = nloc; b.st[1] = nx; }
        const unsigned old = xb_add(&bar[XB_XSUB(b.x)], 1u);
        const unsigned gen = old / nloc;
        if (old + 1u == (gen + 1u) * nloc) {
            __builtin_amdgcn_fence(__ATOMIC_RELEASE, "agent");
            asm volatile("s_waitcnt vmcnt(0)" ::: "memory");
            const unsigned og = xb_add(&bar[XB_TOP], 1u);
            const unsigned tg = og / nx;
            if (og + 1u == (tg + 1u) * nx) xb_add(&bar[XB_TOPGEN], 1u);
            else XB_SPIN(xb_ld(&bar[XB_TOPGEN]) == tg, bar);
            __builtin_amdgcn_fence(__ATOMIC_ACQUIRE, "agent");
            xb_add(&bar[XB_XGEN(b.x)], 1u);
            asm volatile("s_waitcnt vmcnt(0)" ::: "memory");
        } else {
            XB_SPIN(xb_ld(&bar[XB_XGEN(b.x)]) == gen, bar);
            __builtin_amdgcn_fence(__ATOMIC_ACQUIRE, "agent");
            asm volatile("s_waitcnt vmcnt(0)" ::: "memory");
        }
    }
    __syncthreads();
}

constexpr int NWAVES = 8;
#ifndef MK_N_LAUNCHES
#define MK_N_LAUNCHES 1
#endif
constexpr int N_PHASES = 12;
constexpr int N_LAUNCHES = MK_N_LAUNCHES;
static_assert(N_LAUNCHES == 1 || N_LAUNCHES == N_PHASES, "MK_N_LAUNCHES is 1 or 12");
constexpr int DM = 2048, FF = 8192, MP = 8192, MS = 2048, M = MP + MS, NIN = 10240;
constexpr float EPS = 1e-6f, LOG2E = 1.4426950408889634f;
constexpr float QS_A = 0.125f * LOG2E;
constexpr float QS_B = 0.08838834764831845f * LOG2E;
constexpr float LAM_INIT = 0.2f;
constexpr size_t OFF_AKP = 20971520, OFF_AVP = 29360128, OFF_BKP = 37748736, OFF_BVP = 38797312, OFF_AKS = 39845888, OFF_AVS = 41943040, OFF_BKS = 44040192, OFF_BVS = 60817408, OUT_ELEMS = 77594624;
constexpr size_t MiB = 1u << 20;
constexpr size_t WS_CTL = 0, CTL_ZERO_BYTES = 1 * MiB;
constexpr size_t WS_ROPE = 1 * MiB;
constexpr size_t WS_W1 = 2 * MiB, WS_W1D = 66 * MiB, WS_WIN = 98 * MiB, WS_WBR = 138 * MiB, WS_WOUT = 146 * MiB, WS_W2 = 154 * MiB, WS_W2D = 218 * MiB;
constexpr size_t WS_H = 250 * MiB, WS_ACT = 290 * MiB, WS_X1 = 450 * MiB, WS_X2 = 530 * MiB;
constexpr size_t WS_QA = 610 * MiB, WS_KA = 630 * MiB, WS_VA = 650 * MiB, WS_QB = 670 * MiB, WS_KB = 690 * MiB, WS_VB = 710 * MiB, WS_SGA = 730 * MiB, WS_SGB = 770 * MiB, WS_OAB = 810 * MiB, WS_MRG = 850 * MiB, WS_END = 890 * MiB;
constexpr int CW_TMO = 0, CW_BAR = 4096;
constexpr int RING_BYTES = 131072, LDSCTL_OFF = RING_BYTES, MISC_OFF = LDSCTL_OFF + 320, LDS_BYTES = 147456;

__device__ __forceinline__ float wave_sum(float v) {
#pragma unroll
    for (int o = 1; o < 64; o <<= 1) v += __shfl_xor(v, o);
    return v;
}
__device__ __forceinline__ float sigmoid_f(float x) { return __builtin_amdgcn_rcpf(1.f + __builtin_amdgcn_exp2f(-LOG2E * x)); }
__device__ __forceinline__ float bf_lo(unsigned w) { return __builtin_bit_cast(float, w << 16); }
__device__ __forceinline__ float bf_hi(unsigned w) { return __builtin_bit_cast(float, w & 0xffff0000u); }

#define EPI_ARGS const pg8::f32x4 (&acc)[2][2][4][2], const pg8::Unit& un, int wr, int wc, int fr, int fq
using pg8::cvt_pk_bf16;
typedef unsigned u32x2 __attribute__((ext_vector_type(2)));

struct EpiSwiglu {
    static constexpr bool PERM = true, AFTER_DRAIN = false, HAS_MID = false;
    bf16* O;
    __device__ __forceinline__ void operator()(EPI_ARGS) const {
        const int row0 = un.pm * 256 + wr * 64 + fr, col0 = un.pn * 128 + wc * 32 + 8 * fq;
#pragma unroll
        for (int ai = 0; ai < 2; ++ai)
#pragma unroll
            for (int m = 0; m < 4; ++m) {
                bf16* p = O + (size_t)(row0 + ai * 128 + m * 16) * FF + col0;
                const f32x4 g0 = acc[ai][0][m][0], g1 = acc[ai][0][m][1], u0 = acc[ai][1][m][0], u1 = acc[ai][1][m][1];
                float a[8];
#pragma unroll
                for (int j = 0; j < 4; ++j) { a[j] = g0[j] * sigmoid_f(g0[j]) * u0[j]; a[4 + j] = g1[j] * sigmoid_f(g1[j]) * u1[j]; }
                v4u w; w.x = cvt_pk_bf16(a[0], a[1]); w.y = cvt_pk_bf16(a[2], a[3]); w.z = cvt_pk_bf16(a[4], a[5]); w.w = cvt_pk_bf16(a[6], a[7]);
                *(v4u*)p = w;
            }
    }
};
struct EpiResid {
    static constexpr bool PERM = false, AFTER_DRAIN = false, HAS_MID = false;
    const float* in_lo; const float* in_hi; float* out; float scale;
    __device__ __forceinline__ void operator()(EPI_ARGS) const {
        const int row0 = un.pm * 256 + wr * 64 + fr, col0 = un.pn * 256 + wc * 32 + 4 * fq;
        const float* ib = (un.pm < MP / 256) ? in_lo : in_hi - (size_t)MP * DM;
#pragma unroll
        for (int ai = 0; ai < 2; ++ai)
#pragma unroll
            for (int m = 0; m < 4; ++m) {
                const size_t off = (size_t)(row0 + ai * 128 + m * 16) * DM + col0;
#pragma unroll
                for (int bj = 0; bj < 2; ++bj)
#pragma unroll
                    for (int n = 0; n < 2; ++n) *(f32x4*)(out + off + bj * 128 + n * 16) = *(const f32x4*)(ib + off + bj * 128 + n * 16) + acc[ai][bj][m][n] * scale;
            }
    }
};
struct EpiWin {
    static constexpr bool PERM = false, AFTER_DRAIN = false, HAS_MID = false;
    bf16 *QA, *KA, *VA, *QB, *KB, *VB, *SGA, *SGB; float* out; const float* rcos; const float* rsin;
    __device__ __forceinline__ void operator()(EPI_ARGS) const {
        const int reg = un.pn >> 2;
        const bool smp = un.pm >= MP / 256;
        const int row0 = un.pm * 256 + wr * 64 + fr;
        if (reg < 2) {
            const int i0 = 16 * (wc & 1) + 4 * fq;
#pragma unroll
            for (int ai = 0; ai < 2; ++ai)
#pragma unroll
                for (int m = 0; m < 4; ++m) {
                    const int row = row0 + ai * 128 + m * 16;
                    const int pos = smp ? 2048 + ((row - MP) & 63) : (row & 4095);
                    const f32x4 c = *(const f32x4*)(rcos + pos * 32 + i0), s = *(const f32x4*)(rsin + pos * 32 + i0);
#pragma unroll
                    for (int bj = 0; bj < 2; ++bj) {
                        const int cl = 64 * (4 * (un.pn & 3) + 2 * bj + (wc >> 1)) + i0;
                        const f32x4 x1 = acc[ai][bj][m][0], x2 = acc[ai][bj][m][1];
                        f32x4 o1 = x1 * c - x2 * s, o2 = x2 * c + x1 * s;
                        if (reg == 0) {
                            o1 = o1 * QS_A; o2 = o2 * QS_A;
                            u32x2 w1, w2; w1.x = cvt_pk_bf16(o1[0], o1[1]); w1.y = cvt_pk_bf16(o1[2], o1[3]); w2.x = cvt_pk_bf16(o2[0], o2[1]); w2.y = cvt_pk_bf16(o2[2], o2[3]);
                            *(u32x2*)(QA + (size_t)row * 1024 + cl) = w1; *(u32x2*)(QA + (size_t)row * 1024 + cl + 32) = w2;
                        } else {
                            u32x2 w1, w2; w1.x = cvt_pk_bf16(o1[0], o1[1]); w1.y = cvt_pk_bf16(o1[2], o1[3]); w2.x = cvt_pk_bf16(o2[0], o2[1]); w2.y = cvt_pk_bf16(o2[2], o2[3]);
                            *(u32x2*)(KA + (size_t)row * 1024 + cl) = w1; *(u32x2*)(KA + (size_t)row * 1024 + cl + 32) = w2;
                            float* ob = smp ? out + OFF_AKS + (size_t)(row - MP) * 1024 : out + OFF_AKP + (size_t)row * 1024;
                            *(f32x4*)(ob + cl) = o1; *(f32x4*)(ob + cl + 32) = o2;
                        }
                    }
                }
        } else {
            const int rstart = reg < 6 ? reg * 1024 : (reg < 8 ? 6144 : 8192);
            const int cl0 = un.pn * 256 - rstart + wc * 32 + 8 * fq;
            const bool band = smp || ((un.pm & 15) >= 14);
#pragma unroll
            for (int ai = 0; ai < 2; ++ai)
#pragma unroll
                for (int m = 0; m < 4; ++m) {
                    const int row = row0 + ai * 128 + m * 16;
                    size_t brow;
                    if (smp) { const int rr = row - MP; brow = (size_t)(rr >> 6) * 512 + 448 + (rr & 63); }
                    else { const int bb = row >> 12; brow = (size_t)bb * 512 + ((row & 4095) - 3584); }
#pragma unroll
                    for (int bj = 0; bj < 2; ++bj) {
                        const int cl = cl0 + bj * 128;
                        f32x4 v0 = acc[ai][bj][m][0], v1 = acc[ai][bj][m][1];
                        if (reg == 2) {
                            float* ob = (smp ? out + OFF_AVS + (size_t)(row - MP) * 1024 : out + OFF_AVP + (size_t)row * 1024) + cl;
                            *(f32x4*)ob = v0; *(f32x4*)(ob + 4) = v1;
                        } else if (reg == 4 || reg == 5) {
                            if (band) { float* ob = out + (reg == 4 ? (smp ? OFF_BKS : OFF_BKP) : (smp ? OFF_BVS : OFF_BVP)) + brow * 1024 + cl; *(f32x4*)ob = v0; *(f32x4*)(ob + 4) = v1; }
                        } else if (reg == 3) { v0 = v0 * QS_B; v1 = v1 * QS_B; }
                        else {
#pragma unroll
                            for (int j = 0; j < 4; ++j) { v0[j] = sigmoid_f(v0[j]); v1[j] = sigmoid_f(v1[j]); }
                        }
                        v4u w; w.x = cvt_pk_bf16(v0[0], v0[1]); w.y = cvt_pk_bf16(v0[2], v0[3]); w.z = cvt_pk_bf16(v1[0], v1[1]); w.w = cvt_pk_bf16(v1[2], v1[3]);
                        bf16* dst;
                        if (reg < 6) dst = (reg == 2 ? VA : reg == 3 ? QB : reg == 4 ? KB : VB) + (size_t)row * 1024 + cl;
                        else dst = (reg < 8 ? SGA : SGB) + (size_t)row * DM + cl;
                        *(v4u*)dst = w;
                    }
                }
        }
    }
};
struct EpiMerge {
    static constexpr bool PERM = true, AFTER_DRAIN = false, HAS_MID = true;
    const bf16* SGA; const bf16* SGB; bf16* O;
    __device__ __forceinline__ void mid(pg8::f32x4 (&acc)[2][2][4][2], const pg8::Unit& un, int wr, int wc, int fr, int fq) const {
        int row0 = un.pm * 256 + wr * 64 + fr, col0 = un.pn * 256 + wc * 32 + 8 * fq;
        asm volatile("" : "+v"(row0), "+v"(col0));
#pragma unroll
        for (int ai = 0; ai < 2; ++ai)
#pragma unroll
            for (int m = 0; m < 4; ++m)
#pragma unroll
                for (int bj = 0; bj < 2; ++bj) {
                    const size_t off = (size_t)(row0 + ai * 128 + m * 16) * DM + col0 + bj * 128;
                    const v4u a = *(const v4u*)(SGA + off), b = *(const v4u*)(SGB + off);
                    f32x4 r0, r1;
                    r0[0] = bf_lo(a.x) * __builtin_amdgcn_rcpf(bf_lo(b.x)); r0[1] = bf_hi(a.x) * __builtin_amdgcn_rcpf(bf_hi(b.x));
                    r0[2] = bf_lo(a.y) * __builtin_amdgcn_rcpf(bf_lo(b.y)); r0[3] = bf_hi(a.y) * __builtin_amdgcn_rcpf(bf_hi(b.y));
                    r1[0] = bf_lo(a.z) * __builtin_amdgcn_rcpf(bf_lo(b.z)); r1[1] = bf_hi(a.z) * __builtin_amdgcn_rcpf(bf_hi(b.z));
                    r1[2] = bf_lo(a.w) * __builtin_amdgcn_rcpf(bf_lo(b.w)); r1[3] = bf_hi(a.w) * __builtin_amdgcn_rcpf(bf_hi(b.w));
                    acc[ai][bj][m][0] = acc[ai][bj][m][0] * r0; acc[ai][bj][m][1] = acc[ai][bj][m][1] * r1;
                    if (bj == 1) asm volatile("" ::: "memory");
                }
    }
    __device__ __forceinline__ void operator()(EPI_ARGS) const {
        const int row0 = un.pm * 256 + wr * 64 + fr, col0 = un.pn * 256 + wc * 32 + 8 * fq;
#pragma unroll
        for (int ai = 0; ai < 2; ++ai)
#pragma unroll
            for (int m = 0; m < 4; ++m)
#pragma unroll
                for (int bj = 0; bj < 2; ++bj) {
                    const size_t off = (size_t)(row0 + ai * 128 + m * 16) * DM + col0 + bj * 128;
                    const v4u b = *(const v4u*)(SGB + off);
                    const f32x4 v0 = acc[ai][bj][m][0], v1 = acc[ai][bj][m][1];
                    v4u w; w.x = cvt_pk_bf16(v0[0] * bf_lo(b.x), v0[1] * bf_hi(b.x)); w.y = cvt_pk_bf16(v0[2] * bf_lo(b.y), v0[3] * bf_hi(b.y));
                    w.z = cvt_pk_bf16(v1[0] * bf_lo(b.z), v1[1] * bf_hi(b.z)); w.w = cvt_pk_bf16(v1[2] * bf_lo(b.w), v1[3] * bf_hi(b.w));
                    *(v4u*)(O + off) = w;
                    if (bj == 1) asm volatile("" ::: "memory");
                }
    }
};

namespace att {
typedef short bf16x8 __attribute__((ext_vector_type(8)));
typedef short s16x4 __attribute__((ext_vector_type(4)));
typedef float f32x16 __attribute__((ext_vector_type(16)));
typedef float f32x8 __attribute__((ext_vector_type(8)));
typedef unsigned u32x4 __attribute__((ext_vector_type(4)));
#define ATT_LAS __attribute__((address_space(3)))
#define KSWZ(row, colB) ((row) * 256 + ((colB) ^ (((row) & 7) << 4)))
#define SBAR() __builtin_amdgcn_sched_barrier(0)
constexpr float THR = 6.f;
__device__ __forceinline__ int crow(int r, int hi) { return (r & 3) + 8 * (r >> 2) + 4 * hi; }
__device__ __forceinline__ unsigned cvtpk(float lo, float hi) { unsigned r; asm volatile("v_cvt_pk_bf16_f32 %0, %1, %2" : "=v"(r) : "v"(lo), "v"(hi)); return r; }
template <typename TIn> struct Stage;
template <> struct Stage<unsigned short> { using T = bf16x8;
    __device__ static __forceinline__ T ld8(const unsigned short* p) { return *reinterpret_cast<const bf16x8*>(p); }
    __device__ static __forceinline__ bf16x8 tobf(T x) { return x; } };
template <> struct Stage<float> { using T = f32x8;
    __device__ static __forceinline__ T ld8(const float* p) { return *reinterpret_cast<const f32x8*>(p); }
    __device__ static __forceinline__ bf16x8 tobf(T x) { u32x4 w = {cvtpk(x[0], x[1]), cvtpk(x[2], x[3]), cvtpk(x[4], x[5]), cvtpk(x[6], x[7])}; return __builtin_bit_cast(bf16x8, w); } };

__device__ __forceinline__ void partialSM(f32x16& p0, f32x16& p1, float& m_reg, float& alpha) {
    float pmax = p0[0];
#pragma unroll
    for (int r = 1; r < 16; ++r) pmax = fmaxf(pmax, p0[r]);
#pragma unroll
    for (int r = 0; r < 16; ++r) pmax = fmaxf(pmax, p1[r]);
    { auto rr = __builtin_amdgcn_permlane32_swap(__float_as_uint(pmax), __float_as_uint(pmax), false, false); pmax = fmaxf(__uint_as_float(rr[0]), __uint_as_float(rr[1])); }
    float mn;
    if (__builtin_expect(__all(pmax - m_reg <= THR), 1)) { mn = m_reg; alpha = 1.f; }
    else { mn = fmaxf(m_reg, pmax); alpha = __builtin_amdgcn_exp2f(m_reg - mn); m_reg = mn; }
#pragma unroll
    for (int r = 0; r < 16; ++r) { p0[r] = p0[r] - mn; p1[r] = p1[r] - mn; }
#pragma unroll
    for (int r = 0; r < 16; ++r) p0[r] = __builtin_amdgcn_exp2f(p0[r]);
}
__device__ __forceinline__ void finishSM(f32x16& p0, f32x16& p1, float alpha, float& l_reg, bf16x8& pa0, bf16x8& pa1, bf16x8& pa2, bf16x8& pa3) {
#pragma unroll
    for (int r = 0; r < 16; ++r) p1[r] = __builtin_amdgcn_exp2f(p1[r]);
    float ps = 0;
#pragma unroll
    for (int r = 0; r < 16; ++r) ps += p0[r];
#pragma unroll
    for (int r = 0; r < 16; ++r) ps += p1[r];
    { auto rr = __builtin_amdgcn_permlane32_swap(__float_as_uint(ps), __float_as_uint(ps), false, false); ps = __uint_as_float(rr[0]) + __uint_as_float(rr[1]); }
    l_reg = l_reg * alpha + ps;
#define PK4(P, BASE, OUT) do { unsigned a0 = cvtpk(P[BASE + 0], P[BASE + 1]), a1 = cvtpk(P[BASE + 2], P[BASE + 3]);   \
    unsigned b0 = cvtpk(P[BASE + 4], P[BASE + 5]), b1 = cvtpk(P[BASE + 6], P[BASE + 7]);                              \
    auto r0 = __builtin_amdgcn_permlane32_swap(a0, b0, false, false); auto r1 = __builtin_amdgcn_permlane32_swap(a1, b1, false, false); \
    u32x4 w = {r0[0], r1[0], r0[1], r1[1]}; OUT = __builtin_bit_cast(bf16x8, w); } while (0)
    PK4(p0, 0, pa0); PK4(p0, 8, pa1); PK4(p1, 0, pa2); PK4(p1, 8, pa3);
#undef PK4
}
template <int NQ> __device__ __forceinline__ void qkt(f32x16& p0, f32x16& p1, const ATT_LAS char* Ks, const bf16x8* qr, int d0b, int r32, int hi) {
    p0 = f32x16{}; p1 = f32x16{};
#pragma unroll
    for (int d = 0; d < NQ; ++d) { const int cb = ((d0b + d) * 16 + hi * 8) * 2;
        const bf16x8 b0 = *reinterpret_cast<const ATT_LAS bf16x8*>(Ks + KSWZ(r32, cb));
        const bf16x8 b1 = *reinterpret_cast<const ATT_LAS bf16x8*>(Ks + KSWZ(32 + r32, cb));
        p0 = __builtin_amdgcn_mfma_f32_32x32x16_bf16(b0, qr[d], p0, 0, 0, 0);
        p1 = __builtin_amdgcn_mfma_f32_32x32x16_bf16(b1, qr[d], p1, 0, 0, 0); }
}
__device__ __forceinline__ int v_st(int k, int c) { const int kk = (k & ~0xC) | ((k & 4) << 1) | ((k & 8) >> 1); return ((kk >> 3) * 4 + (c >> 5)) * 512 + ((kk & 7) * 32 + (c & 31)) * 2; }
__device__ __forceinline__ int v_rd_base(int lane) { return ((lane & 3) << 3) | (((lane >> 2) & 3) << 6) | (((lane >> 4) & 1) << 5) | (((lane >> 5) & 1) << 8); }
constexpr int v_rd_off(int d0, int ks, int half) { return d0 * 512 + ks * 4096 + half * 2048; }
template <int OFF> __device__ __forceinline__ s16x4 tr_read(int vb) { s16x4 r; asm volatile("ds_read_b64_tr_b16 %0, %1 offset:%2" : "=&v"(r) : "v"(vb), "i"(OFF) : "memory"); return r; }
template <int D0> __device__ __forceinline__ void pv_one(f32x16& od, int vb, bf16x8 pa0, bf16x8 pa1, bf16x8 pa2, bf16x8 pa3) {
    const s16x4 l0 = tr_read<v_rd_off(D0, 0, 0)>(vb), h0 = tr_read<v_rd_off(D0, 0, 1)>(vb), l1 = tr_read<v_rd_off(D0, 1, 0)>(vb), h1 = tr_read<v_rd_off(D0, 1, 1)>(vb);
    const s16x4 l2 = tr_read<v_rd_off(D0, 2, 0)>(vb), h2 = tr_read<v_rd_off(D0, 2, 1)>(vb), l3 = tr_read<v_rd_off(D0, 3, 0)>(vb), h3 = tr_read<v_rd_off(D0, 3, 1)>(vb);
    asm volatile("s_waitcnt lgkmcnt(0)" ::: "memory"); SBAR();
#define PKV(L, H) (bf16x8){L[0], L[1], L[2], L[3], H[0], H[1], H[2], H[3]}
    od = __builtin_amdgcn_mfma_f32_32x32x16_bf16(pa0, PKV(l0, h0), od, 0, 0, 0);
    od = __builtin_amdgcn_mfma_f32_32x32x16_bf16(pa1, PKV(l1, h1), od, 0, 0, 0);
    od = __builtin_amdgcn_mfma_f32_32x32x16_bf16(pa2, PKV(l2, h2), od, 0, 0, 0);
    od = __builtin_amdgcn_mfma_f32_32x32x16_bf16(pa3, PKV(l3, h3), od, 0, 0, 0);
#undef PKV
}
__device__ __forceinline__ void pv_d0(f32x16* o, int vb, bf16x8 pa0, bf16x8 pa1, bf16x8 pa2, bf16x8 pa3) {
    pv_one<0>(o[0], vb, pa0, pa1, pa2, pa3); pv_one<1>(o[1], vb, pa0, pa1, pa2, pa3); pv_one<2>(o[2], vb, pa0, pa1, pa2, pa3); pv_one<3>(o[3], vb, pa0, pa1, pa2, pa3);
}
struct AttnP { const bf16 *QA, *KA, *VA, *QB, *KB, *VB; bf16* OAB; const float *cak, *cav, *cbk, *cbv; float* out; const float* relb; const float* subln; float lam; };

template <int KIND> __device__ __forceinline__ void attn_unit(const AttnP& P, const int u, ATT_LAS char* lds) {
    constexpr bool IS_A = KIND < 2, IS_S = (KIND & 1) != 0;
    constexpr int NQ = IS_A ? 4 : 8, SDEPTH = (KIND == 0) ? 2 : 1;
    using TS = typename std::conditional<IS_S, float, unsigned short>::type;
    using St = Stage<TS>;
    const int tid = threadIdx.x, wid = __builtin_amdgcn_readfirstlane(tid >> 6), lane = tid & 63, r32 = lane & 31, hi = lane >> 5;
    ATT_LAS char* V_lds = lds; ATT_LAS char* K_lds = lds + 32768;
    ATT_LAS float* wsc = (ATT_LAS float*)(lds + 65536) + wid * 64; ATT_LAS float* li_l = wsc; ATT_LAS float* al_l = wsc + 32;
    ATT_LAS float* tab = (ATT_LAS float*)(lds + 65536 + 2048);
    int h, NT, tsplit, map = 0, pslot = 0, cw = 0, kc0 = 0, qrow; bool active = true, lastmask = false;
    const bf16* Qw; const TS *Kt0, *Kt1, *Vt0, *Vt1;
    float* okb = nullptr; float* ovb = nullptr;
    if constexpr (KIND == 0) {
        const int qt = u & 31, b = u >> 8; h = (u >> 5) & 7; map = wid >> 2; pslot = wid & 3;
        qrow = b * 4096 + qt * 128 + pslot * 32; Qw = P.QA + (size_t)qrow * 1024 + h * 128 + map * 64;
        Kt0 = Kt1 = (const TS*)(P.KA + (size_t)b * 4096 * 1024 + h * 128); Vt0 = Vt1 = (const TS*)(P.VA + (size_t)b * 4096 * 1024 + h * 128);
        NT = 2 * qt + 2; tsplit = NT; lastmask = pslot < 2;
    } else if constexpr (KIND == 1) {
        const int b = u >> 3; h = u & 7; active = wid < 4; map = (wid >> 1) & 1; pslot = wid & 1;
        qrow = MP + b * 64 + pslot * 32; Qw = P.QA + (size_t)qrow * 1024 + h * 128 + map * 64;
        Kt0 = (const TS*)(P.cak + ((size_t)b * 2048 * 8 + h) * 128); Vt0 = (const TS*)(P.cav + ((size_t)b * 2048 * 8 + h) * 128);
        Kt1 = (const TS*)(P.out + OFF_AKS + ((size_t)b * 64 * 8 + h) * 128); Vt1 = (const TS*)(P.out + OFF_AVS + ((size_t)b * 64 * 8 + h) * 128);
        NT = 34; tsplit = 32;
    } else if constexpr (KIND == 2) {
        const int qg = u & 15, b = u >> 7; h = (u >> 4) & 7; const int c0 = 4 * qg; cw = c0 + (wid >> 1);
        qrow = b * 4096 + cw * 64 + (wid & 1) * 32; Qw = P.QB + (size_t)qrow * 1024 + h * 128;
        kc0 = c0 > 8 ? c0 - 8 : 0; NT = c0 + 4 - kc0; tsplit = NT;
        Kt0 = Kt1 = (const TS*)(P.KB + ((size_t)b * 4096 + kc0 * 64) * 1024 + h * 128); Vt0 = Vt1 = (const TS*)(P.VB + ((size_t)b * 4096 + kc0 * 64) * 1024 + h * 128);
    } else {
        const int b = u >> 3; h = u & 7; active = wid < 2; cw = 8;
        qrow = MP + b * 64 + (wid & 1) * 32; Qw = P.QB + (size_t)qrow * 1024 + h * 128;
        Kt0 = (const TS*)(P.cbk + ((size_t)b * 512 * 8 + h) * 128); Vt0 = (const TS*)(P.cbv + ((size_t)b * 512 * 8 + h) * 128);
        Kt1 = (const TS*)(P.out + OFF_BKS + (((size_t)b * 512 + 448) * 8 + h) * 128); Vt1 = (const TS*)(P.out + OFF_BVS + (((size_t)b * 512 + 448) * 8 + h) * 128);
        okb = P.out + OFF_BKS + ((size_t)b * 512 * 8 + h) * 128; ovb = P.out + OFF_BVS + ((size_t)b * 512 * 8 + h) * 128;
        NT = 10; tsplit = 8;
    }
    const int d0b = IS_A ? 4 * map : 0;
    const int qi = 32 * (wid & 1) + r32;
    float c256 = 0.f;
    if constexpr (!IS_A) { if (tid < 257) tab[tid] = P.relb[h * 257 + tid] * LOG2E; c256 = P.relb[h * 257 + 256] * LOG2E; }
    float m_reg = -1e30f, l_reg = 0.f; f32x16 o[4] = {}; bf16x8 qr[NQ];
#pragma unroll
    for (int d = 0; d < NQ; ++d) qr[d] = *reinterpret_cast<const bf16x8*>(Qw + (size_t)r32 * 1024 + d * 16 + hi * 8);
    const int sr = tid >> 4, sc = (tid & 15) * 8, vst0 = v_st(sr, sc), vst1 = v_st(32 + sr, sc);
    const int vb0 = (int)(unsigned)(uintptr_t)V_lds + v_rd_base(lane);
    struct { typename St::T vs0, vs1, ks0, ks1; } sr_[SDEPTH];
#define SLOAD(i, t) do { if (!IS_S || (t) <= tsplit) { const TS* kb_ = ((t) < tsplit) ? Kt0 + (size_t)(t) * 65536 : Kt1; const TS* vb_ = ((t) < tsplit) ? Vt0 + (size_t)(t) * 65536 : Vt1; \
        sr_[i].vs0 = St::ld8(vb_ + sr * 1024 + sc); sr_[i].vs1 = St::ld8(vb_ + (32 + sr) * 1024 + sc); \
        sr_[i].ks0 = St::ld8(kb_ + sr * 1024 + sc); sr_[i].ks1 = St::ld8(kb_ + (32 + sr) * 1024 + sc); } } while (0)
#define SWRITE(bi, i, t) do { \
        *(ATT_LAS bf16x8*)(V_lds + (bi) * 16384 + vst0) = St::tobf(sr_[i].vs0); *(ATT_LAS bf16x8*)(V_lds + (bi) * 16384 + vst1) = St::tobf(sr_[i].vs1); \
        *(ATT_LAS bf16x8*)(K_lds + (bi) * 16384 + KSWZ(sr, sc * 2)) = St::tobf(sr_[i].ks0); *(ATT_LAS bf16x8*)(K_lds + (bi) * 16384 + KSWZ(32 + sr, sc * 2)) = St::tobf(sr_[i].ks1); \
        if constexpr (KIND == 3) { if ((t) >= 1 && (t) <= 7) { const size_t o_ = (size_t)((t) - 1) * 65536 + sr * 1024 + sc; \
            *(typename St::T*)(okb + o_) = sr_[i].ks0; *(typename St::T*)(okb + o_ + 32 * 1024) = sr_[i].ks1; *(typename St::T*)(ovb + o_) = sr_[i].vs0; *(typename St::T*)(ovb + o_ + 32 * 1024) = sr_[i].vs1; } } } while (0)
#define SWAIT() do { if constexpr (SDEPTH == 2) asm volatile("s_waitcnt vmcnt(4)" ::: "memory"); } while (0)
#define RESC(a) do { if (__any((a) < 1.f)) { if (hi == 0) al_l[r32] = (a); asm volatile("s_waitcnt lgkmcnt(0)" ::: "memory"); \
        _Pragma("unroll") for (int d_ = 0; d_ < 4; ++d_) _Pragma("unroll") for (int r_ = 0; r_ < 16; ++r_) o[d_][r_] *= al_l[crow(r_, hi)]; } } while (0)
#define SCORE(P0_, P1_, bi, t) do { if (active) { bool val_ = true; int dc_ = 0; \
        if constexpr (KIND == 0) { if ((t) == NT - 1 && lastmask) val_ = false; } \
        if constexpr (KIND >= 2) { dc_ = cw - (kc0 + (t)); val_ = (dc_ >= 0 && dc_ <= 8); } \
        if (val_) { qkt<NQ>(P0_, P1_, K_lds + (bi) * 16384, qr, d0b, r32, hi); \
            if constexpr (KIND >= 2) { \
                if (dc_ >= 3) { _Pragma("unroll") for (int r_ = 0; r_ < 16; ++r_) { P0_[r_] += c256; P1_[r_] += c256; } } \
                else { const int base_ = 64 * dc_ + qi + 128; \
                    _Pragma("unroll") for (int r_ = 0; r_ < 16; ++r_) { int i0_ = base_ - crow(r_, hi); int i1_ = i0_ - 32; i0_ = i0_ > 256 ? 256 : i0_; i1_ = i1_ > 256 ? 256 : i1_; P0_[r_] += tab[i0_]; P1_[r_] += tab[i1_]; if ((r_ & 3) == 3) asm volatile("" ::: "memory"); } } } } \
        else { _Pragma("unroll") for (int r_ = 0; r_ < 16; ++r_) { P0_[r_] = -INFINITY; P1_[r_] = -INFINITY; } } } } while (0)
    f32x16 pA0, pA1; float alA = 1.f; bf16x8 pa0, pa1, pa2, pa3;
    if constexpr (KIND != 0) {
        const int ntl = IS_S ? tsplit + 1 : NT;
        SLOAD(0, 0); SWRITE(0, 0, 0); __syncthreads();
        for (int t = 0; t < ntl; ++t) {
            if (t + 1 < ntl) SLOAD(0, t + 1);
            if (active) {
                SCORE(pA0, pA1, (t & 1), t); partialSM(pA0, pA1, m_reg, alA); RESC(alA);
                finishSM(pA0, pA1, alA, l_reg, pa0, pa1, pa2, pa3); SBAR();
                pv_d0(o, vb0 + (t & 1) * 16384, pa0, pa1, pa2, pa3);
            }
            if (t + 1 < ntl) SWRITE(((t + 1) & 1), 0, t + 1);
            __syncthreads();
        }
    } else {
        f32x16 pB0, pB1; float alB = 1.f;
        constexpr int SE = 0, SO = SDEPTH - 1;
        SLOAD(SE, 0); SWRITE(0, SE, 0); __syncthreads();
        SCORE(pA0, pA1, 0, 0); if (active) partialSM(pA0, pA1, m_reg, alA);
        SLOAD(SO, 1); if constexpr (SDEPTH == 2) { if (2 < NT) SLOAD(SE, 2); }
        SWAIT(); SWRITE(1, SO, 1); __syncthreads();
        for (int j = 1; j + 1 < NT; j += 2) {
            SBAR(); SCORE(pB0, pB1, 1, j);
            if (active) finishSM(pA0, pA1, alA, l_reg, pa0, pa1, pa2, pa3); SBAR();
            SLOAD(SO, j + SDEPTH); SBAR();
            if (active) { pv_d0(o, vb0, pa0, pa1, pa2, pa3); partialSM(pB0, pB1, m_reg, alB); }
            __syncthreads(); SWAIT(); SWRITE(0, SE, j + 1);
            if (active) RESC(alB); __syncthreads();
            SBAR(); SCORE(pA0, pA1, 0, j + 1);
            if (active) finishSM(pB0, pB1, alB, l_reg, pa0, pa1, pa2, pa3); SBAR();
            if (SDEPTH == 1 || j + 3 < NT) SLOAD(SE, j + 1 + SDEPTH); SBAR();
            if (active) { pv_d0(o, vb0 + 16384, pa0, pa1, pa2, pa3); partialSM(pA0, pA1, m_reg, alA); }
            __syncthreads(); SWAIT(); SWRITE(1, SO, j + 2);
            if (active) RESC(alA); __syncthreads();
        }
        if constexpr (!IS_S) { SBAR(); SCORE(pB0, pB1, 1, NT - 1); }
        if (active) finishSM(pA0, pA1, alA, l_reg, pa0, pa1, pa2, pa3); SBAR();
        if (active) pv_d0(o, vb0, pa0, pa1, pa2, pa3);
        if constexpr (!IS_S) {
            partialSM(pB0, pB1, m_reg, alB); RESC(alB);
            finishSM(pB0, pB1, alB, l_reg, pa0, pa1, pa2, pa3); SBAR();
            pv_d0(o, vb0 + 16384, pa0, pa1, pa2, pa3);
        }
    }
    if (active) {
        if (hi == 0) li_l[r32] = l_reg; asm volatile("s_waitcnt lgkmcnt(0)" ::: "memory");
#pragma unroll
        for (int r = 0; r < 16; ++r) { const float rl = __builtin_amdgcn_rcpf(li_l[crow(r, hi)]);
#pragma unroll
            for (int d0 = 0; d0 < 4; ++d0) o[d0][r] *= rl; }
    }
    if constexpr (IS_A) {
        __syncthreads();
        ATT_LAS float* xb = (ATT_LAS float*)lds + pslot * 4096 + lane;
        if (active && map == 1) {
#pragma unroll
            for (int d0 = 0; d0 < 4; ++d0)
#pragma unroll
                for (int r = 0; r < 16; ++r) xb[(d0 * 16 + r) * 64] = o[d0][r];
        }
        __syncthreads();
        if (active && map == 0) {
            const float lam = P.lam;
#pragma unroll
            for (int d0 = 0; d0 < 4; ++d0)
#pragma unroll
                for (int r = 0; r < 16; ++r) o[d0][r] -= lam * xb[(d0 * 16 + r) * 64];
            float g[4];
#pragma unroll
            for (int d0 = 0; d0 < 4; ++d0) g[d0] = P.subln[32 * d0 + r32] * (1.0f - LAM_INIT);
#pragma unroll
            for (int r = 0; r < 16; ++r) {
                float ss = o[0][r] * o[0][r] + o[1][r] * o[1][r] + o[2][r] * o[2][r] + o[3][r] * o[3][r];
                ss += __shfl_xor(ss, 1); ss += __shfl_xor(ss, 2); ss += __shfl_xor(ss, 4); ss += __shfl_xor(ss, 8); ss += __shfl_xor(ss, 16);
                const float rn = 1.0f / sqrtf(ss * (1.0f / 128.0f) + EPS);
                bf16* op = P.OAB + (size_t)(qrow + crow(r, hi)) * DM + h * 128 + r32;
#pragma unroll
                for (int d0 = 0; d0 < 4; ++d0) op[32 * d0] = (bf16)f2bf(o[d0][r] * rn * g[d0]);
            }
        }
    } else {
        if (active) {
#pragma unroll
            for (int r = 0; r < 16; ++r) { bf16* op = P.OAB + (size_t)(qrow + crow(r, hi)) * DM + 1024 + h * 128 + r32;
#pragma unroll
                for (int d0 = 0; d0 < 4; ++d0) op[32 * d0] = (bf16)f2bf(o[d0][r]); }
        }
    }
    __syncthreads();
#undef SLOAD
#undef SWRITE
#undef SWAIT
#undef RESC
#undef SCORE
}
#undef SBAR
}

__device__ __forceinline__ int perm32inv(int c) { return 16 * ((c >> 2) & 1) + 4 * (c >> 3) + (c & 3); }
template <int MAP> __device__ __forceinline__ int rowmap(int n) {
    if constexpr (MAP == 1) return 256 * (n >> 7) + (n & 127);
    else if constexpr (MAP == 2) return 256 * (n >> 7) + 128 + (n & 127);
    else if constexpr (MAP == 3) return n < 2048 ? ((n & ~48) | ((n & 16) << 1) | ((n & 32) >> 1)) : ((n & ~31) + perm32inv(n & 31));
    else return n;
}
template <int MAP> __device__ __forceinline__ void tr_item(const float* W, int N, bf16* WT, int Kd, int koff, LAS float* scr, int item, int lane) {
    const int nblk = N / 32, kb = item / nblk, nb = item % nblk, k0 = 64 * kb, n0 = 32 * nb;
#pragma unroll 8
    for (int i = 0; i < 32; ++i) { const int kk = 2 * i + (lane >> 5); scr[kk * 33 + (lane & 31)] = W[(size_t)(k0 + kk) * N + n0 + (lane & 31)]; }
    LDS_WAIT(); asm volatile("" ::: "memory");
    const int c = lane & 7;
#pragma unroll
    for (int j = 0; j < 4; ++j) { const int n = (lane >> 3) + 8 * j; const LAS float* s = scr + (8 * c) * 33 + n;
        v4u o; o.x = pk2(s[0 * 33], s[1 * 33]); o.y = pk2(s[2 * 33], s[3 * 33]); o.z = pk2(s[4 * 33], s[5 * 33]); o.w = pk2(s[6 * 33], s[7 * 33]);
        *(GAS v4u*)(WT + (size_t)rowmap<MAP>(n0 + n) * Kd + koff + k0 + 8 * c) = o; }
    LDS_WAIT(); asm volatile("" ::: "memory");
}
__device__ __forceinline__ void norm_rows_bf16(const float* xlo, const float* xhi, const float* g, bf16* out, int gw, int NGW, int lane) {
    f32x4 gv[8];
#pragma unroll
    for (int j = 0; j < 8; ++j) gv[j] = ((const f32x4*)g)[lane + 64 * j];
    for (int m = gw; m < M; m += NGW) {
        const f32x4* xr = (const f32x4*)(m < MP ? xlo + (size_t)m * DM : xhi + (size_t)(m - MP) * DM) + lane;
        f32x4 v[8]; float s = 0.f;
#pragma unroll
        for (int j = 0; j < 8; ++j) { v[j] = xr[64 * j]; s += (v[j].x * v[j].x + v[j].y * v[j].y) + (v[j].z * v[j].z + v[j].w * v[j].w); }
        const float rstd = 1.0f / sqrtf(wave_sum(s) * (1.0f / DM) + EPS);
        unsigned long long* o8 = (unsigned long long*)(out + (size_t)m * DM) + lane;
#pragma unroll
        for (int j = 0; j < 8; ++j) { const f32x4 y = v[j] * rstd * gv[j]; o8[64 * j] = (unsigned long long)pk2(y.x, y.y) | ((unsigned long long)pk2(y.z, y.w) << 32); }
    }
}
__device__ __forceinline__ void norm_rows_f32(const float* x, const float* g, float* out, int gw, int NGW, int lane) {
    f32x4 gv[8];
#pragma unroll
    for (int j = 0; j < 8; ++j) gv[j] = ((const f32x4*)g)[lane + 64 * j];
    for (int m = gw; m < M; m += NGW) {
        const f32x4* xr = (const f32x4*)(x + (size_t)m * DM) + lane;
        f32x4 v[8]; float s = 0.f;
#pragma unroll
        for (int j = 0; j < 8; ++j) { v[j] = xr[64 * j]; s += (v[j].x * v[j].x + v[j].y * v[j].y) + (v[j].z * v[j].z + v[j].w * v[j].w); }
        const float rstd = 1.0f / sqrtf(wave_sum(s) * (1.0f / DM) + EPS);
        f32x4* o = (f32x4*)(out + (size_t)m * DM) + lane;
#pragma unroll
        for (int j = 0; j < 8; ++j) o[64 * j] = v[j] * rstd * gv[j];
    }
}
__constant__ float ROPE_INV[32] = {
    1.000000000e+00f, 7.498942614e-01f, 5.623413324e-01f, 4.216965139e-01f, 3.162277639e-01f, 2.371373773e-01f, 1.778279394e-01f, 1.333521307e-01f,
    1.000000015e-01f, 7.498941571e-02f, 5.623413250e-02f, 4.216965288e-02f, 3.162277490e-02f, 2.371373773e-02f, 1.778279431e-02f, 1.333521493e-02f,
    9.999999776e-03f, 7.498941850e-03f, 5.623413250e-03f, 4.216964822e-03f, 3.162277630e-03f, 2.371373586e-03f, 1.778279431e-03f, 1.333521446e-03f,
    1.000000047e-03f, 7.498942432e-04f, 5.623413017e-04f, 4.216965172e-04f, 3.162277571e-04f, 2.371373703e-04f, 1.778279402e-04f, 1.333521504e-04f };

struct Args { const float* in[26]; float* out; unsigned char* ws; int ph_lo, ph_hi, li, pad; };
__global__ void __launch_bounds__(NWAVES * 64, 2) fwd_kernel(Args args) {
    extern __shared__ __attribute__((aligned(16))) unsigned char lds_raw[];
    LAS unsigned char* lds = (LAS unsigned char*)lds_raw;
    volatile LAS unsigned* MISC = (volatile LAS unsigned*)(lds + MISC_OFF);
    const int tid = threadIdx.x, lane = tid & 63, wave = __builtin_amdgcn_readfirstlane(tid >> 6);
    const int G = gridDim.x; int vcu; { const int bx = blockIdx.x; vcu = (G % 8 == 0) ? (bx % 8) * (G / 8) + bx / 8 : bx; }
    const int gw = vcu * NWAVES + wave, NGW = G * NWAVES;
    unsigned char* ws = args.ws;
    gu32* ctl = (gu32*)(ws + WS_CTL);
    for (int i = tid; i < (LDS_BYTES - LDSCTL_OFF) / 4; i += NWAVES * 64) ((LAS unsigned*)(lds + LDSCTL_OFF))[i] = 0u;
    __syncthreads();
    XcdBarrier bar; bar.bar = (unsigned*)(ctl + CW_BAR); bar.x = 0; bar.st = nullptr;
    if (N_LAUNCHES == 1) bar = xcd_barrier_post((unsigned*)(ctl + CW_BAR), MISC + 8);
#define GRID_BAR() do { if (N_LAUNCHES == 1) xcd_barrier(bar); } while (0)
    const int lo = args.ph_lo, hi = args.ph_hi;
#ifndef PHMASK
#define PHMASK 0xFFF
#endif
#define IN(k) ((((PHMASK) >> (k)) & 1) && lo <= (k) && (k) < hi)
#define BOTH(k) (IN(k) && IN((k) + 1))
    const float* x_prompt = args.in[0]; const float* x_sample = args.in[1];
    bf16* W1 = (bf16*)(ws + WS_W1); bf16* W1D = (bf16*)(ws + WS_W1D); bf16* WIN = (bf16*)(ws + WS_WIN); bf16* WBR = (bf16*)(ws + WS_WBR); bf16* WOUT = (bf16*)(ws + WS_WOUT);
    bf16* W2 = (bf16*)(ws + WS_W2); bf16* W2D = (bf16*)(ws + WS_W2D);
    bf16* H = (bf16*)(ws + WS_H); bf16* ACT = (bf16*)(ws + WS_ACT); float* X1 = (float*)(ws + WS_X1); float* X2 = (float*)(ws + WS_X2);
    bf16* QA = (bf16*)(ws + WS_QA); bf16* KA = (bf16*)(ws + WS_KA); bf16* VA = (bf16*)(ws + WS_VA); bf16* QB = (bf16*)(ws + WS_QB); bf16* KB = (bf16*)(ws + WS_KB); bf16* VB = (bf16*)(ws + WS_VB);
    bf16* SGA = (bf16*)(ws + WS_SGA); bf16* SGB = (bf16*)(ws + WS_SGB); bf16* OAB = (bf16*)(ws + WS_OAB); bf16* MRG = (bf16*)(ws + WS_MRG);
    float* RCOS = (float*)(ws + WS_ROPE); float* RSIN = RCOS + 4096 * 32;
#define RUN_GEMM(EpiT, E_, A_, B_, N_, K_) do { pg8::Gemm g_{(const pg8::bf16_t*)(A_), (const pg8::bf16_t*)(B_), M, (N_), (K_)}; pg8::StaticOrder S_; S_.init(M, (N_), G, (int)blockIdx.x); \
        pg8::gemm_phase<EpiT, pg8::StaticOrder, true, true>(lds, g_, S_, E_); } while (0)

    if (IN(0)) {
        LAS float* scr = (LAS float*)(lds + wave * 16384);
        constexpr int I_FF = 32 * 256, I_D = 128 * 64, I_IN = 32 * 320, I_BR = 16 * 64, I_O = 32 * 64;
        constexpr int NITEMS = 2 * (2 * I_FF + I_D) + I_IN + 2 * I_BR + I_O;
        for (int it = gw; it < NITEMS; it += NGW) {
            int r = it;
            if (r < I_FF) { tr_item<1>(args.in[7], FF, W1, DM, 0, scr, r, lane); continue; } r -= I_FF;
            if (r < I_FF) { tr_item<2>(args.in[8], FF, W1, DM, 0, scr, r, lane); continue; } r -= I_FF;
            if (r < I_D) { tr_item<0>(args.in[9], DM, W1D, FF, 0, scr, r, lane); continue; } r -= I_D;
            if (r < I_IN) { tr_item<3>(args.in[11], NIN, WIN, DM, 0, scr, r, lane); continue; } r -= I_IN;
            if (r < I_BR) { tr_item<0>(args.in[18], DM, WBR, DM, 0, scr, r, lane); continue; } r -= I_BR;
            if (r < I_BR) { tr_item<0>(args.in[19], DM, WBR, DM, 1024, scr, r, lane); continue; } r -= I_BR;
            if (r < I_O) { tr_item<0>(args.in[20], DM, WOUT, DM, 0, scr, r, lane); continue; } r -= I_O;
            if (r < I_FF) { tr_item<1>(args.in[22], FF, W2, DM, 0, scr, r, lane); continue; } r -= I_FF;
            if (r < I_FF) { tr_item<2>(args.in[23], FF, W2, DM, 0, scr, r, lane); continue; } r -= I_FF;
            tr_item<0>(args.in[24], DM, W2D, FF, 0, scr, r, lane);
        }
        for (int e = vcu * (NWAVES * 64) + tid; e < 4096 * 32; e += G * NWAVES * 64) {
            const int pos = e >> 5, i = e & 31;
            const float ang = (float)pos * ROPE_INV[i];
            double rev = (double)ang * 0.15915494309189535; rev -= __builtin_rint(rev);
            const float fr = (float)rev;
            RCOS[e] = __builtin_amdgcn_cosf(fr); RSIN[e] = __builtin_amdgcn_sinf(fr);
        }
        norm_rows_bf16(x_prompt, x_sample, args.in[6], H, gw, NGW, lane);
        if (BOTH(0)) GRID_BAR();
    }
    if (IN(1)) { EpiSwiglu E{ACT}; RUN_GEMM(EpiSwiglu, E, H, W1, 2 * FF, DM); if (BOTH(1)) GRID_BAR(); }
    if (IN(2)) { EpiResid E{x_prompt, x_sample, X1, 0.5f}; RUN_GEMM(EpiResid, E, ACT, W1D, DM, FF); if (BOTH(2)) GRID_BAR(); }
    if (IN(3)) { norm_rows_bf16(X1, X1 + (size_t)MP * DM, args.in[10], H, gw, NGW, lane); if (BOTH(3)) GRID_BAR(); }
    if (IN(4)) { EpiWin E{QA, KA, VA, QB, KB, VB, SGA, SGB, args.out, RCOS, RSIN}; RUN_GEMM(EpiWin, E, H, WIN, NIN, DM); if (BOTH(4)) GRID_BAR(); }
    if (IN(5)) {
        float lam;
        { const float s1 = wave_sum(args.in[12][lane] * args.in[13][lane]), s2 = wave_sum(args.in[14][lane] * args.in[15][lane]); lam = expf(s1) - expf(s2) + LAM_INIT; }
        const att::AttnP AP{QA, KA, VA, QB, KB, VB, OAB, args.in[2], args.in[3], args.in[4], args.in[5], args.out, args.in[17], args.in[16], lam};
        ATT_LAS char* al = (ATT_LAS char*)lds;
#ifndef KMASK
#define KMASK 15
#endif
        if (KMASK & 2) for (int u = vcu; u < 256; u += G) att::attn_unit<1>(AP, u, al);
        if (KMASK & 1) for (int i = vcu; i < 512; i += G) { const int v = i & 255, s = v & 15, qt = (i >> 8) ? 31 - s : s; att::attn_unit<0>(AP, (v >> 4) * 32 + qt, al); }
        if (KMASK & 4) for (int u = vcu; u < 256; u += G) att::attn_unit<2>(AP, u, al);
        if (KMASK & 8) for (int u = vcu; u < 256; u += G) att::attn_unit<3>(AP, u, al);
        if (BOTH(5)) GRID_BAR();
    }
    if (IN(6)) { EpiMerge E{SGA, SGB, MRG}; RUN_GEMM(EpiMerge, E, OAB, WBR, DM, DM); if (BOTH(6)) GRID_BAR(); }
    if (IN(7)) { EpiResid E{X1, X1 + (size_t)MP * DM, X2, 1.0f}; RUN_GEMM(EpiResid, E, MRG, WOUT, DM, DM); if (BOTH(7)) GRID_BAR(); }
    if (IN(8)) { norm_rows_bf16(X2, X2 + (size_t)MP * DM, args.in[21], H, gw, NGW, lane); if (BOTH(8)) GRID_BAR(); }
    if (IN(9)) { EpiSwiglu E{ACT}; RUN_GEMM(EpiSwiglu, E, H, W2, 2 * FF, DM); if (BOTH(9)) GRID_BAR(); }
    if (IN(10)) { EpiResid E{X2, X2 + (size_t)MP * DM, X1, 0.5f}; RUN_GEMM(EpiResid, E, ACT, W2D, DM, FF); if (BOTH(10)) GRID_BAR(); }
    if (IN(11)) { norm_rows_f32(X1, args.in[25], args.out, gw, NGW, lane); }
#undef IN
#undef BOTH
}

extern "C" void kernel_launch(void* const* d_in, const int* in_sizes, int n_in, void* d_out, int out_size, void* d_ws, size_t ws_size, hipStream_t stream) {
    static int grid = 0;
    if (grid == 0) {
        if (n_in != 26 || in_sizes[0] != MP * DM || in_sizes[1] != MS * DM || (size_t)out_size != OUT_ELEMS || ws_size < WS_END) {
            fprintf(stderr, "kernel_launch: shape mismatch: n_in %d in0 %d in1 %d out %d ws %zu (need >= %zu); nothing launched\n", n_in, n_in > 0 ? in_sizes[0] : -1, n_in > 1 ? in_sizes[1] : -1, out_size, ws_size, (size_t)WS_END); grid = -1; return; }
        int dev = 0, cus = 0, per_cu = 0;
        if (hipGetDevice(&dev) != hipSuccess || hipDeviceGetAttribute(&cus, hipDeviceAttributeMultiprocessorCount, dev) != hipSuccess) { fprintf(stderr, "kernel_launch: device query failed\n"); grid = -1; return; }
        if (hipFuncSetAttribute((const void*)fwd_kernel, hipFuncAttributeMaxDynamicSharedMemorySize, LDS_BYTES) != hipSuccess) { fprintf(stderr, "kernel_launch: hipFuncSetAttribute failed\n"); grid = -1; return; }
        if (hipOccupancyMaxActiveBlocksPerMultiprocessor(&per_cu, (const void*)fwd_kernel, NWAVES * 64, LDS_BYTES) != hipSuccess || per_cu < 1) { fprintf(stderr, "kernel_launch: occupancy query reports %d workgroups per CU; nothing launched\n", per_cu); (void)hipGetLastError(); grid = -1; return; }
        (void)hipGetLastError();
        grid = cus;
    }
    if (grid < 0) return;
    if (hipMemsetAsync((char*)d_ws + WS_CTL, 0, CTL_ZERO_BYTES, stream) != hipSuccess) { fprintf(stderr, "kernel_launch: memset failed\n"); return; }
    Args a{};
    for (int i = 0; i < 26; ++i) a.in[i] = (const float*)d_in[i];
    a.out = (float*)d_out; a.ws = (unsigned char*)d_ws;
    for (int li = 0; li < N_LAUNCHES; ++li) {
        a.ph_lo = (N_LAUNCHES == 1) ? 0 : li; a.ph_hi = (N_LAUNCHES == 1) ? N_PHASES : li + 1; a.li = li; a.pad = 0;
        hipLaunchKernelGGL(fwd_kernel, dim3(grid), dim3(NWAVES * 64), LDS_BYTES, stream, a);
        const hipError_t le = hipPeekAtLastError();
        if (le != hipSuccess) { fprintf(stderr, "kernel_launch: launch %d failed: %s\n", li, hipGetErrorName(le)); break; }
    }
}
```

```cpp
#include <hip/hip_runtime.h>
#include <cstdio>
#include <cstdint>
#include <type_traits>
namespace pg8 {
#define PG8_LAS __attribute__((address_space(3)))
typedef unsigned short bf16_t;
typedef short bf16x8 __attribute__((ext_vector_type(8)));
typedef float f32x4 __attribute__((ext_vector_type(4)));
typedef unsigned u32x4 __attribute__((ext_vector_type(4)));
constexpr int BM = 256, BK = 64, HALF = 128, HTB = HALF * BK * 2  , STAGE_BYTES = 8 * HTB, NXCD = 8, WGM = 8;

__host__ __device__ __forceinline__ int lds_byte(int r, int c) { const int st = (r >> 4) * 2 + (c >> 5), rr = r & 15, cc = c & 31, ob = rr * 64 + cc * 2; return st * 1024 + (ob ^ (((ob >> 9) & 1) << 5)); }
__host__ __device__ __forceinline__ void stage_rc(int b, int& R, int& C) { const int st = b / 1024, sb = b % 1024, swz = sb ^ (((sb >> 9) & 1) << 5); R = (st >> 1) * 16 + swz / 64; C = (st & 1) * 32 + (swz % 64) / 2; }
__host__ __device__ __forceinline__ int perm32(int rho) { const int n = rho >> 4, i = rho & 15; return 8 * (i >> 2) + 4 * n + (i & 3); }

struct Unit { int pm, pn, k0, nk, role, slab; };
struct Gemm { const bf16_t* A; const bf16_t* Bt; int M, N, K; };

struct StaticOrder {
    int nM, nN, nwg, G, c, KT;
    __host__ __device__ __forceinline__ void init(int M, int N, int K, int G_, int c_) { nM = M / BM; nN = N / BM; nwg = nM * nN; G = G_; c = c_; KT = K / BK; }
    __host__ __device__ __forceinline__ bool next(int i, Unit& u) const {
        const long L = (long)i * G + c; if (L >= nwg) return false;
        int wgid = (int)L; { const int q = nwg / NXCD, r = nwg % NXCD, xcd = wgid % NXCD, off = wgid / NXCD; wgid = (xcd < r ? xcd * (q + 1) : r * (q + 1) + (xcd - r) * q) + off; }
        const int nig = WGM * nN, gid = wgid / nig, fm = gid * WGM, gsz = (nM - fm) < WGM ? (nM - fm) : WGM;
        u.pm = fm + ((wgid % nig) % gsz); u.pn = (wgid % nig) / gsz; u.k0 = 0; u.nk = KT; u.role = 0; u.slab = 0; return true;
    }
    __device__ __forceinline__ void a_ready(const Unit&) const {}
    __device__ __forceinline__ void done(const Unit&) const {}
};

struct SplitOrder {
    int nM, nN, KT, G, c, F, NF, j, r, q4, ntiles; bool enabled;
    float* slabs; unsigned* cnt; unsigned* tmo;
    __device__ __forceinline__ void init(int M, int N, int K, int G_, int c_, float* slabs_, unsigned* cnt_, unsigned* tmo_) {
        nM = M / BM; nN = N / BM; KT = K / BK; G = G_; c = c_; slabs = slabs_; cnt = cnt_; tmo = tmo_;
        ntiles = nM * nN; F = ntiles / G; NF = F * G; q4 = KT / 4;
        enabled = (G % 32 == 0) && ((ntiles - NF) * 4 == G) && (KT % 8 == 0) && F >= 1;
        const int xcd = c % NXCD, idx = c / NXCD; j = xcd * (G / 32) + idx / 4; r = idx % 4;
    }
    __device__ __forceinline__ void tile(int q, Unit& u) const { const int nig = WGM * nN, gid = q / nig, fm = gid * WGM, gsz = (nM - fm) < WGM ? (nM - fm) : WGM, w = q % nig; u.pm = fm + w % gsz; u.pn = w / gsz; }
    __device__ __forceinline__ void full_tile(int L, Unit& u) const { const int wgid = (L % NXCD) * (NF / NXCD) + L / NXCD; tile(wgid, u); u.k0 = 0; u.nk = KT; u.role = 0; u.slab = 0; }
    __device__ __forceinline__ bool next(int i, Unit& u) const {
        if (!enabled) { const int L = i * G + c; if (L >= ntiles) return false; tile(L, u); u.k0 = 0; u.nk = KT; u.role = 0; u.slab = 0; return true; }
        if (r < 3) {
            if (i == 0) { tile(NF + j, u); u.k0 = r * q4; u.nk = q4; u.role = 1; u.slab = j * 3 + r; return true; }
            if (i <= F) { full_tile((i - 1) * G + c, u); return true; }
            return false;
        }
        if (i < F) { full_tile(i * G + c, u); return true; }
        if (i == F) { tile(NF + j, u); u.k0 = 3 * q4; u.nk = q4; u.role = 2; u.slab = j * 3; return true; }
        return false;
    }
};
__device__ __forceinline__ unsigned cvt_pk_bf16(float lo, float hi) { unsigned r; asm volatile("v_cvt_pk_bf16_f32 %0, %1, %2" : "=v"(r) : "v"(lo), "v"(hi)); return r; }
__device__ __forceinline__ void sk_store(const f32x4 (&acc)[2][2][4][2], float* slab, unsigned* cnt, int wid, int lane) {
    u32x4* p = (u32x4*)slab + (wid * 16 * 64 + lane);
#pragma unroll
    for (int e = 0; e < 16; ++e) { const f32x4 v0 = acc[e >> 3][(e >> 2) & 1][e & 3][0], v1 = acc[e >> 3][(e >> 2) & 1][e & 3][1];
        u32x4 w; w.x = cvt_pk_bf16(v0[0], v0[1]); w.y = cvt_pk_bf16(v0[2], v0[3]); w.z = cvt_pk_bf16(v1[0], v1[1]); w.w = cvt_pk_bf16(v1[2], v1[3]);
        u32x4* q = p + e * 64;
        asm volatile("global_store_dwordx4 %0, %1, off sc1\n\ts_nop 1" :: "v"(q), "v"(w) : "memory"); }
    asm volatile("s_waitcnt vmcnt(0)" ::: "memory");
    if (lane == 0) __hip_atomic_fetch_add(cnt, 1u, __ATOMIC_RELAXED, __HIP_MEMORY_SCOPE_AGENT);
}
__device__ __forceinline__ void sk_wait(unsigned* cnt, unsigned need, unsigned* tmo, int lane) {
    unsigned spins = 0;
    while ((unsigned)__builtin_amdgcn_readfirstlane(__hip_atomic_load(cnt, __ATOMIC_RELAXED, __HIP_MEMORY_SCOPE_AGENT)) < need) {
        __builtin_amdgcn_s_sleep(2);
        if (++spins > (1u << 20)) { if (lane == 0) __hip_atomic_store(tmo, 1u, __ATOMIC_RELAXED, __HIP_MEMORY_SCOPE_AGENT); break; }
    }
    __builtin_amdgcn_fence(__ATOMIC_ACQUIRE, "agent");
}
__device__ __forceinline__ void sk_load(f32x4 (&acc)[2][2][4][2], const float* slab, int wid, int lane) {
    typedef __attribute__((address_space(1))) const u32x4 gu4;
    int t_ = threadIdx.x; asm volatile("" : "+v"(t_));
    const int lofs = (t_ >> 6) * 16 * 64 + (t_ & 63);
    gu4* p = (gu4*)((const u32x4*)slab + lofs);
#pragma unroll
    for (int g = 0; g < 2; ++g) {
        u32x4 t[24];
#pragma unroll
        for (int e = 0; e < 8; ++e) { const int i = 8 * g + e; t[3 * e] = p[i * 64]; t[3 * e + 1] = p[i * 64 + 8192]; t[3 * e + 2] = p[i * 64 + 16384]; }
        asm volatile("" :: "v"(t[0]), "v"(t[1]), "v"(t[2]), "v"(t[3]), "v"(t[4]), "v"(t[5]), "v"(t[6]), "v"(t[7]), "v"(t[8]), "v"(t[9]), "v"(t[10]), "v"(t[11]),
                          "v"(t[12]), "v"(t[13]), "v"(t[14]), "v"(t[15]), "v"(t[16]), "v"(t[17]), "v"(t[18]), "v"(t[19]), "v"(t[20]), "v"(t[21]), "v"(t[22]), "v"(t[23]) : "memory");
#pragma unroll
        for (int e = 0; e < 8; ++e) { const int i = 8 * g + e; const u32x4 a = t[3 * e], b = t[3 * e + 1], c = t[3 * e + 2];
#define BFLO(w) __builtin_bit_cast(float, (w) << 16)
#define BFHI(w) __builtin_bit_cast(float, (w) & 0xffff0000u)
            acc[i >> 3][(i >> 2) & 1][i & 3][0] = (f32x4){(BFLO(a.x) + BFLO(b.x)) + BFLO(c.x), (BFHI(a.x) + BFHI(b.x)) + BFHI(c.x), (BFLO(a.y) + BFLO(b.y)) + BFLO(c.y), (BFHI(a.y) + BFHI(b.y)) + BFHI(c.y)};
            acc[i >> 3][(i >> 2) & 1][i & 3][1] = (f32x4){(BFLO(a.z) + BFLO(b.z)) + BFLO(c.z), (BFHI(a.z) + BFHI(b.z)) + BFHI(c.z), (BFLO(a.w) + BFLO(b.w)) + BFLO(c.w), (BFHI(a.w) + BFHI(b.w)) + BFHI(c.w)};
#undef BFLO
#undef BFHI
        }
    }
}

typedef float f32x2 __attribute__((ext_vector_type(2)));
#ifndef EPI_BUMP
#define EPI_BUMP 0
#endif
#ifndef GEMM_NT_B
#define GEMM_NT_B 0
#endif
template <class Epi, class Sched, bool ALIGN_EPI = false, bool SP2 = false, bool SPLITK = false>
__device__ __forceinline__ void gemm_phase(PG8_LAS unsigned char* lds, const Gemm g, const Sched& S, const Epi& E) {
    const int tid = threadIdx.x, wid = __builtin_amdgcn_readfirstlane(tid >> 6), lane = tid & 63, wr = wid >> 2, wc = wid & 3, fr = lane & 15, fq = lane >> 4;
    static_assert(SP2, "the K-loop trip below is the two-super-phase schedule (the four-phase variant was slower and is gone)");
    const int K = g.K;
    unsigned voffA[2], voffB[2];
#pragma unroll
    for (int i = 0; i < 2; ++i) { int R, C; stage_rc(tid * 16 + i * 8192, R, C); const int Rb = Epi::PERM ? ((R & ~31) + perm32(R & 31)) : R;
        voffA[i] = (unsigned)(R * K + C) * 2u; voffB[i] = (unsigned)(Rb * K + C) * 2u; }
    const size_t kstep = (size_t)(BK * 2);
    const size_t hstep = (size_t)HALF * K * 2;
    const size_t tstep = 2 * hstep;
    const unsigned ldsw = (unsigned)wid * 1024u;
    const int aoff = lds_byte(wr * 64 + fr, fq * 8), boff = lds_byte(wc * 32 + fr, fq * 8);
#define PG8_SA(b, h) (((b) * 2 + (h)) * HTB)
#define PG8_SB(b, h) ((4 + (b) * 2 + (h)) * HTB)
#define PG8_STAGE(bufoff, gbase, voff) do { _Pragma("unroll") for (int _i = 0; _i < 2; ++_i) \
        __builtin_amdgcn_global_load_lds((const unsigned*)((const char*)(gbase) + (voff)[_i]), (PG8_LAS unsigned*)(lds + (bufoff) + ldsw + _i * 8192), 16, 0, 0); } while (0)
#define PG8_STAGEB(bufoff, gbase, voff) do { _Pragma("unroll") for (int _i = 0; _i < 2; ++_i) \
        __builtin_amdgcn_global_load_lds((const unsigned*)((const char*)(gbase) + (voff)[_i]), (PG8_LAS unsigned*)(lds + (bufoff) + ldsw + _i * 8192), 16, 0, GEMM_NT_B); } while (0)
#define PG8_LDA(dst, b, h) do { _Pragma("unroll") for (int m = 0; m < 4; ++m) _Pragma("unroll") for (int k = 0; k < 2; ++k) dst[m][k] = *(const PG8_LAS bf16x8*)(lds + PG8_SA(b, h) + aoff + m * 2048 + k * 1024); } while (0)
#define PG8_LDB(dst, b, h) do { _Pragma("unroll") for (int n = 0; n < 2; ++n) _Pragma("unroll") for (int k = 0; k < 2; ++k) dst[n][k] = *(const PG8_LAS bf16x8*)(lds + PG8_SB(b, h) + boff + n * 2048 + k * 1024); } while (0)
#define PG8_MMA(ai, bj, At, Bt) do { __builtin_amdgcn_s_setprio(1); _Pragma("unroll") for (int m = 0; m < 4; ++m) _Pragma("unroll") for (int n = 0; n < 2; ++n) _Pragma("unroll") for (int k = 0; k < 2; ++k) \
        acc[ai][bj][m][n] = __builtin_amdgcn_mfma_f32_16x16x32_bf16(Bt[n][k], At[m][k], acc[ai][bj][m][n], 0, 0, 0); __builtin_amdgcn_s_setprio(0); } while (0)
#define PG8_WAIT_V(n) asm volatile("s_waitcnt vmcnt(" #n ")" ::: "memory")
#define PG8_WAIT_L(n) asm volatile("s_waitcnt lgkmcnt(" #n ")" ::: "memory")
#define PG8_BAR __builtin_amdgcn_s_barrier()
#define PG8_SCHED __builtin_amdgcn_sched_barrier(0)
    Unit cur, nxt; int ui = 0;
    if (!S.next(0, cur)) { if constexpr (Epi::DEFER) E.bar_only(); return; }
    f32x4 acc[2][2][4][2];
#pragma unroll
    for (int a = 0; a < 2; ++a)
#pragma unroll
        for (int b = 0; b < 2; ++b)
#pragma unroll
            for (int m = 0; m < 4; ++m)
#pragma unroll
                for (int n = 0; n < 2; ++n) acc[a][b][m][n] = (f32x4){0.f, 0.f, 0.f, 0.f};
    float pre[8] = {0.f, 0.f, 0.f, 0.f, 0.f, 0.f, 0.f, 0.f};
    bf16x8 At[4][2], B0[2][2], B1[2][2];
    const char* cA = (const char*)g.A + (size_t)cur.pm * tstep + (size_t)cur.k0 * kstep; const char* cB = (const char*)g.Bt + (size_t)cur.pn * tstep + (size_t)cur.k0 * kstep;
    if constexpr (SP2) {
        PG8_STAGEB(PG8_SB(0, 0), cB, voffB); PG8_STAGEB(PG8_SB(0, 1), cB + hstep, voffB); PG8_STAGE(PG8_SA(0, 0), cA, voffA); PG8_STAGE(PG8_SA(0, 1), cA + hstep, voffA);
        if (wr == 1) PG8_BAR;
        PG8_WAIT_V(2); PG8_BAR;
        PG8_STAGEB(PG8_SB(1, 0), cB + kstep, voffB); PG8_STAGE(PG8_SA(1, 0), cA + kstep, voffA); PG8_STAGEB(PG8_SB(1, 1), cB + hstep + kstep, voffB);
        PG8_WAIT_V(6); PG8_BAR;
    } else {
        PG8_STAGEB(PG8_SB(0, 0), cB, voffB); PG8_STAGE(PG8_SA(0, 0), cA, voffA); PG8_STAGEB(PG8_SB(0, 1), cB + hstep, voffB); PG8_STAGE(PG8_SA(0, 1), cA + hstep, voffA);
        if (wr == 1) PG8_BAR;
        PG8_WAIT_V(4); PG8_BAR;
        PG8_STAGEB(PG8_SB(1, 0), cB + kstep, voffB); PG8_STAGE(PG8_SA(1, 0), cA + kstep, voffA); PG8_STAGEB(PG8_SB(1, 1), cB + hstep + kstep, voffB);
        PG8_WAIT_V(6); PG8_BAR;
    }
    constexpr bool BUMP = (((EPI_BUMP) >> Epi::EPI_ID) & 1) && Epi::NVM > 0;
    bool ep_prev = false;
    for (;;) {
        const bool has_next = S.next(ui + 1, nxt);
        const char* nA = has_next ? (const char*)g.A + (size_t)nxt.pm * tstep + (size_t)nxt.k0 * kstep : cA; const char* nB = has_next ? (const char*)g.Bt + (size_t)nxt.pn * tstep + (size_t)nxt.k0 * kstep : cB;
        const int nt = cur.nk;
#define PG8_WAIT_VM(mode) asm volatile("s_waitcnt vmcnt(%1)\n\ts_cmp_eq_u32 %0, 1\n\ts_cbranch_scc1 1f\n\ts_waitcnt vmcnt(16)\n\ts_cmp_eq_u32 %0, 2\n\ts_cbranch_scc1 1f\n\ts_waitcnt vmcnt(8)\n1:" \
            :: "s"(mode), "n"(8 + (Epi::NVM > 8 ? Epi::NVM : 8)) : "memory", "scc")
#define PG8_WAIT_VP(n, np) do { if constexpr (Epi::HAS_PRE || BUMP) PG8_WAIT_VM(wm); else PG8_WAIT_V(n); } while (0)
#define PG8_WAIT_VQ(n, np) do { if constexpr (Epi::HAS_PRE) PG8_WAIT_VM(wm3); else PG8_WAIT_V(n); } while (0)
        for (int t = 0; t < nt; t += 2) {
            if constexpr (Epi::HAS_MID) { if (t > 0 && cur.k0 + t == Epi::KMID) E.mid(acc, cur, wr, wc, fr, fq); }
            const bool last = (t == nt - 2), first = ep_prev && t == 0;
            const int wm = __builtin_amdgcn_readfirstlane((Epi::HAS_PRE && last) ? 2 : ((BUMP && first) ? 1 : 0)), wm3 = __builtin_amdgcn_readfirstlane((Epi::HAS_PRE && last) ? 2 : 0);
            const char* a1 = cA + (size_t)(t + 1) * kstep;
            const char* a2 = last ? nA : cA + (size_t)(t + 2) * kstep; const char* b2 = last ? nB : cB + (size_t)(t + 2) * kstep;
            const char* a3 = a2 + kstep; const char* b3 = b2 + kstep;
            PG8_LDB(B0, 0, 0); PG8_LDB(B1, 0, 1); PG8_SCHED; PG8_LDA(At, 0, 0); PG8_STAGE(PG8_SA(1, 1), a1 + hstep, voffA);
            if constexpr (Epi::HAS_PRE) { if (last) E.pre(pre, cur, wr, fr); }
            PG8_WAIT_VP(8, 16); PG8_WAIT_L(0); PG8_BAR; PG8_MMA(0, 0, At, B0); PG8_MMA(0, 1, At, B1); PG8_BAR; PG8_SCHED;
            PG8_LDA(At, 0, 1); PG8_STAGEB(PG8_SB(0, 0), b2, voffB); PG8_STAGEB(PG8_SB(0, 1), b2 + hstep, voffB); PG8_STAGE(PG8_SA(0, 0), a2, voffA);
            PG8_WAIT_VP(8, 16); PG8_WAIT_L(0); PG8_BAR; PG8_MMA(1, 0, At, B0); PG8_MMA(1, 1, At, B1); PG8_BAR; PG8_SCHED;
            PG8_LDB(B0, 1, 0); PG8_LDB(B1, 1, 1); PG8_SCHED; PG8_LDA(At, 1, 0); PG8_STAGE(PG8_SA(0, 1), a2 + hstep, voffA);
            PG8_WAIT_VQ(8, 16); PG8_WAIT_L(0); PG8_BAR; PG8_MMA(0, 0, At, B0); PG8_MMA(0, 1, At, B1); PG8_BAR; PG8_SCHED;
            PG8_LDA(At, 1, 1); PG8_STAGEB(PG8_SB(1, 0), b3, voffB); PG8_STAGEB(PG8_SB(1, 1), b3 + hstep, voffB); PG8_STAGE(PG8_SA(1, 0), a3, voffA);
            PG8_WAIT_V(8);
            PG8_WAIT_L(0); PG8_BAR; PG8_MMA(1, 0, At, B0); PG8_MMA(1, 1, At, B1); PG8_BAR; PG8_SCHED;
        }
#undef PG8_WAIT_VP
#undef PG8_WAIT_VQ
#undef PG8_WAIT_VM
        if constexpr (ALIGN_EPI) { if (wr == 0) PG8_BAR; }
        if constexpr (Epi::DEFER) {
            bool part = false; if constexpr (SPLITK) part = (cur.role == 1);
            if (part) { sk_store(acc, S.slabs + (size_t)cur.slab * 32768, S.cnt + (cur.slab / 3) * 16, wid, lane); if (!has_next) E.bar_only(); }
            else E.fin(acc, cur, wr, wc, fr, fq, !has_next);
        } else
        if constexpr (SPLITK) {
            if (cur.role == 1) { if constexpr (Epi::HAS_MID) { if (cur.k0 + cur.nk <= Epi::KMID) E.mid(acc, cur, wr, wc, fr, fq); }
                sk_store(acc, S.slabs + (size_t)cur.slab * 32768, S.cnt + (cur.slab / 3) * 16, wid, lane); }
            else { E(acc, cur, wr, wc, fr, fq, pre); }
        } else { E(acc, cur, wr, wc, fr, fq, pre); }
        if (!has_next) break;
        ep_prev = true; if constexpr (SPLITK) ep_prev = (cur.role != 1);
        bool inherit = false;
        if constexpr (SPLITK) inherit = (nxt.role == 2);
        if constexpr (SPLITK) { if (inherit) { sk_wait(S.cnt + (nxt.slab / 3) * 16, 24u, S.tmo, lane); sk_load(acc, S.slabs + (size_t)nxt.slab * 32768, wid, lane); } }
        if (!inherit) {
#pragma unroll
            for (int a = 0; a < 2; ++a)
#pragma unroll
                for (int b = 0; b < 2; ++b)
#pragma unroll
                    for (int m = 0; m < 4; ++m)
#pragma unroll
                        for (int n = 0; n < 2; ++n) acc[a][b][m][n] = (f32x4){0.f, 0.f, 0.f, 0.f};
        }
        cur = nxt; cA = nA; cB = nB; ++ui;
        if constexpr (ALIGN_EPI) { if (wr == 1) PG8_BAR; }
    }
    if constexpr (Epi::DEFER) for (int j = 0; j < ui; ++j) { Unit u; if (S.next(j, u)) { bool pj = false; if constexpr (SPLITK) pj = (u.role == 1); if (!pj) E.fix(acc, u, wr, wc, fr, fq); } }
    PG8_WAIT_V(0);
    if constexpr (!ALIGN_EPI) { if (wr == 0) PG8_BAR; }
    PG8_BAR;
#undef PG8_SA
#undef PG8_SB
#undef PG8_STAGE
#undef PG8_STAGEB
#undef PG8_LDA
#undef PG8_LDB
#undef PG8_MMA
#undef PG8_WAIT_V
#undef PG8_WAIT_L
#undef PG8_BAR
#undef PG8_SCHED
}
}
#define GAS __attribute__((address_space(1)))
#define LAS __attribute__((address_space(3)))
typedef unsigned short bf16;
typedef unsigned v4u __attribute__((ext_vector_type(4)));
typedef float f32x4 __attribute__((ext_vector_type(4)));
typedef short bf16x8 __attribute__((ext_vector_type(8)));
typedef GAS unsigned gu32;
typedef GAS unsigned long long gu64;
#define RLX_AGENT __ATOMIC_RELAXED, __HIP_MEMORY_SCOPE_AGENT
#define LDS_WAIT() asm volatile("s_waitcnt lgkmcnt(0)" ::: "memory")
#define VM_WAIT() asm volatile("s_waitcnt vmcnt(0)" ::: "memory")
__device__ __forceinline__ unsigned long long rt() { return __builtin_amdgcn_s_memrealtime(); }
__device__ __forceinline__ unsigned f2bf(float f) { unsigned u = __builtin_bit_cast(unsigned, f); return (u + 0x7fffu + ((u >> 16) & 1u)) >> 16; }
__device__ __forceinline__ unsigned pk2(float lo, float hi) { return f2bf(lo) | (f2bf(hi) << 16); }

#define XB_TMO      128
#define XB_XCNT(j)  (256  + 64 * (j))
#define XB_XSUB(j)  (1280 + 64 * (j))
#define XB_XGEN(j)  (2304 + 64 * (j))
#define XB_TOP      3328
#define XB_TOPGEN   3392
#define XCD_BAR_WORDS 3456
#define XB_SPIN_CAP (1u << 18)

__device__ __forceinline__ unsigned xb_ld(unsigned* p)              { return __hip_atomic_load(p, __ATOMIC_RELAXED, __HIP_MEMORY_SCOPE_AGENT); }
__device__ __forceinline__ unsigned xb_add(unsigned* p, unsigned v) { return __hip_atomic_fetch_add(p, v, __ATOMIC_RELAXED, __HIP_MEMORY_SCOPE_AGENT); }
__device__ __forceinline__ unsigned xb_xcc_id() { return (unsigned)__builtin_amdgcn_s_getreg((3 << 11) | 20) & 0xFu; }
#define XB_SPIN(cond, bar) do { unsigned _sp = 0; while (cond) { __builtin_amdgcn_s_sleep(1); \
    if ((++_sp & 255u) == 0u) { if (xb_ld(&(bar)[XB_TMO])) break; if (_sp > XB_SPIN_CAP) { atomicAdd(&(bar)[XB_TMO], 1u); break; } } } } while (0)

struct XcdBarrier {
    unsigned* bar; unsigned x;
    volatile LAS unsigned* st;
};

__device__ __forceinline__ XcdBarrier xcd_barrier_post(unsigned* bar, volatile LAS unsigned* st) {
    XcdBarrier b; b.bar = bar; b.x = xb_xcc_id(); b.st = st;
    if (threadIdx.x == 0) (void)xb_add(&bar[XB_XCNT(b.x)], 1u);
    return b;
}
__device__ __forceinline__ void xcd_barrier_complete(unsigned* bar, unsigned x, unsigned& nloc, unsigned& nx) {
    const unsigned G = gridDim.x * gridDim.y * gridDim.z;
    unsigned sum, cnt, mine, sp = 0u;
    for (;;) {
        sum = 0u; cnt = 0u; mine = 0u;
#pragma unroll
        for (unsigned j = 0; j < 16; ++j) { const unsigned c = xb_ld(&bar[XB_XCNT(j)]); sum += c; cnt += (c > 0u) ? 1u : 0u; mine = (j == x) ? c : mine; }
        if (sum == G) break;
        __builtin_amdgcn_s_sleep(1);
        if ((++sp & 255u) == 0u) { if (xb_ld(&bar[XB_TMO])) break; if (sp > XB_SPIN_CAP) { atomicAdd(&bar[XB_TMO], 1u); break; } }
    }
    nloc = mine > 0u ? mine : 1u; nx = cnt > 0u ? cnt : 1u;
}

__device__ __forceinline__ void xcd_barrier(const XcdBarrier& b) {
    asm volatile("s_waitcnt vmcnt(0)" ::: "memory");
    __syncthreads();
    if (threadIdx.x == 0) {
        unsigned* bar = b.bar;
        __builtin_amdgcn_s_waitcnt(0);
        unsigned nloc = b.st[0], nx = b.st[1];
        if (nloc == 0u) { xcd_barrier_complete(bar, b.x, nloc, nx); b.st[0] = nloc; b.st[1] = nx; }
        const unsigned old = xb_add(&bar[XB_XSUB(b.x)], 1u);
        const unsigned gen = old / nloc;
        if (old + 1u == (gen + 1u) * nloc) {
            __builtin_amdgcn_fence(__ATOMIC_RELEASE, "agent");
            asm volatile("s_waitcnt vmcnt(0)" ::: "memory");
            const unsigned og = xb_add(&bar[XB_TOP], 1u);
            const unsigned tg = og / nx;
            if (og + 1u == (tg + 1u) * nx) xb_add(&bar[XB_TOPGEN], 1u);
            else XB_SPIN(xb_ld(&bar[XB_TOPGEN]) == tg, bar);
            __builtin_amdgcn_fence(__ATOMIC_ACQUIRE, "agent");
            xb_add(&bar[XB_XGEN(b.x)], 1u);
            asm volatile("s_waitcnt vmcnt(0)" ::: "memory");
        } else {
            XB_SPIN(xb_ld(&bar[XB_XGEN(b.x)]) == gen, bar);
            __builtin_amdgcn_fence(__ATOMIC_ACQUIRE, "agent");
            asm volatile("s_waitcnt vmcnt(0)" ::: "memory");
        }
    }
    __syncthreads();
}
__device__ __forceinline__ void xcd_barrier_later(const XcdBarrier& b) {
    asm volatile("s_waitcnt vmcnt(0)" ::: "memory");
    __syncthreads();
    if (threadIdx.x == 0) {
        unsigned* bar = b.bar;
        __builtin_amdgcn_s_waitcnt(0);
        unsigned nloc = b.st[0], nx = b.st[1];
        const unsigned old = xb_add(&bar[XB_XSUB(b.x)], 1u);
        const unsigned gen = old / nloc;
        if (old + 1u == (gen + 1u) * nloc) {
            __builtin_amdgcn_fence(__ATOMIC_RELEASE, "agent");
            asm volatile("s_waitcnt vmcnt(0)" ::: "memory");
            const unsigned og = xb_add(&bar[XB_TOP], 1u);
            const unsigned tg = og / nx;
            if (og + 1u == (tg + 1u) * nx) xb_add(&bar[XB_TOPGEN], 1u);
            else XB_SPIN(xb_ld(&bar[XB_TOPGEN]) == tg, bar);
            __builtin_amdgcn_fence(__ATOMIC_ACQUIRE, "agent");
            xb_add(&bar[XB_XGEN(b.x)], 1u);
            asm volatile("s_waitcnt vmcnt(0)" ::: "memory");
        } else {
            XB_SPIN(xb_ld(&bar[XB_XGEN(b.x)]) == gen, bar);
            __builtin_amdgcn_fence(__ATOMIC_ACQUIRE, "agent");
            asm volatile("s_waitcnt vmcnt(0)" ::: "memory");
        }
    }
    __syncthreads();
}

constexpr int NWAVES = 8;
#ifndef MK_N_LAUNCHES
#define MK_N_LAUNCHES 1
#endif
constexpr int N_PHASES = 12;
constexpr int N_LAUNCHES = MK_N_LAUNCHES;
static_assert(N_LAUNCHES == 1 || N_LAUNCHES == N_PHASES, "MK_N_LAUNCHES is 1 or 12");
constexpr int DM = 2048, FF = 8192, MP = 8192, MS = 2048, M = MP + MS, NIN = 10240;
#ifndef NORM_FOLD
#define NORM_FOLD 1
#endif
constexpr float EPS = 1e-6f, LOG2E = 1.4426950408889634f;
constexpr float QS_A = 0.125f * LOG2E;
constexpr float QS_B = 0.08838834764831845f * LOG2E;
constexpr float LAM_INIT = 0.2f;
constexpr size_t OFF_AKP = 20971520, OFF_AVP = 29360128, OFF_BKP = 37748736, OFF_BVP = 38797312, OFF_AKS = 39845888, OFF_AVS = 41943040, OFF_BKS = 44040192, OFF_BVS = 60817408, OUT_ELEMS = 77594624;
constexpr size_t MiB = 1u << 20;
constexpr size_t WS_CTL = 0, CTL_ZERO_BYTES = 1 * MiB;
constexpr size_t WS_ROPE = 1 * MiB;
constexpr size_t WS_W1 = 2 * MiB, WS_W1D = 66 * MiB, WS_WIN = 98 * MiB, WS_WBR = 138 * MiB, WS_WOUT = 146 * MiB, WS_W2 = 154 * MiB, WS_W2D = 218 * MiB;
constexpr size_t WS_H = 250 * MiB, WS_ACT = 290 * MiB, WS_X1 = 450 * MiB, WS_X2 = 530 * MiB;
constexpr size_t WS_QA = 610 * MiB, WS_KA = 630 * MiB, WS_VA = 650 * MiB, WS_QB = 670 * MiB, WS_KB = 690 * MiB, WS_VB = 710 * MiB, WS_SGA = 730 * MiB, WS_SGB = 770 * MiB, WS_OAB = 810 * MiB, WS_MRG = 850 * MiB, WS_SLAB = 890 * MiB  , SLAB_BANK = 48 * MiB, WS_END = 1130 * MiB;
constexpr int CW_RS = 65536;
constexpr int CW_TMO = 0, CW_BAR = 4096, CW_SK = 16384, SK_BANK = 256 * 16;
constexpr int RING_BYTES = 131072, LDSCTL_OFF = RING_BYTES, MISC_OFF = LDSCTL_OFF + 320, LDS_BYTES = 147456;

__device__ __forceinline__ float wave_sum(float v) {
#pragma unroll
    for (int o = 1; o < 64; o <<= 1) v += __shfl_xor(v, o);
    return v;
}
__device__ __forceinline__ float sigmoid_f(float x) { return __builtin_amdgcn_rcpf(1.f + __builtin_amdgcn_exp2f(-LOG2E * x)); }
__device__ __forceinline__ float bf_lo(unsigned w) { return __builtin_bit_cast(float, w << 16); }
__device__ __forceinline__ float bf_hi(unsigned w) { return __builtin_bit_cast(float, w & 0xffff0000u); }

#ifndef NT_ACT
#define NT_ACT 1
#endif
#define EPI_ARGS const pg8::f32x4 (&acc)[2][2][4][2], const pg8::Unit& un, int wr, int wc, int fr, int fq, const float (&pre)[8]
using pg8::cvt_pk_bf16;
typedef unsigned u32x2 __attribute__((ext_vector_type(2)));

#ifndef PRE_ASM
#define PRE_ASM 1
#endif
#if PRE_ASM
#define PRE_LOAD(dst, ptr, byteoff) asm volatile("global_load_dword %0, %1, off offset:%2 sc1" : "=v"(dst) : "v"(ptr), "n"(byteoff))
#else
#define PRE_LOAD(dst, ptr, byteoff) dst = __hip_atomic_load((const float*)((const char*)(ptr) + (byteoff)), __ATOMIC_RELAXED, __HIP_MEMORY_SCOPE_AGENT)
#endif
template <bool SCALE> struct EpiSwiglu {
    static constexpr int EPI_ID = 0;
    static constexpr bool DEFER = false;
    static constexpr int NVM = 8;
    static constexpr bool PERM = true, AFTER_DRAIN = false, HAS_MID = false, HAS_PRE = SCALE;
    __device__ __forceinline__ void pre(float (&p)[8], const pg8::Unit& un, int wr, int fr) const {
        int ro = wr * 64 + fr; asm volatile("" : "+v"(ro));
        const float* r = rowsum + un.pm * 256 + ro;
        PRE_LOAD(p[0], r, 0); PRE_LOAD(p[1], r, 64); PRE_LOAD(p[2], r, 128); PRE_LOAD(p[3], r, 192); PRE_LOAD(p[4], r, 512); PRE_LOAD(p[5], r, 576); PRE_LOAD(p[6], r, 640); PRE_LOAD(p[7], r, 704); }
    bf16* O; const float* rowsum;
    __device__ __forceinline__ void operator()(EPI_ARGS) const {
        const int row0 = un.pm * 256 + wr * 64 + fr, col0 = un.pn * 128 + wc * 32 + 8 * fq;
        float rs[2][4];
#pragma unroll
        for (int ai = 0; ai < 2; ++ai)
#pragma unroll
            for (int m = 0; m < 4; ++m) rs[ai][m] = SCALE ? __builtin_amdgcn_rsqf(pre[ai * 4 + m] * (1.0f / DM) + EPS) : 1.0f;
#pragma unroll
        for (int ai = 0; ai < 2; ++ai)
#pragma unroll
            for (int m = 0; m < 4; ++m) {
                bf16* p = O + (size_t)(row0 + ai * 128 + m * 16) * FF + col0;
                f32x4 g0 = acc[ai][0][m][0], g1 = acc[ai][0][m][1], u0 = acc[ai][1][m][0], u1 = acc[ai][1][m][1];
                if (SCALE) { g0 = g0 * rs[ai][m]; g1 = g1 * rs[ai][m]; u0 = u0 * rs[ai][m]; u1 = u1 * rs[ai][m]; }
                float a[8];
#pragma unroll
                for (int j = 0; j < 4; ++j) { a[j] = g0[j] * sigmoid_f(g0[j]) * u0[j]; a[4 + j] = g1[j] * sigmoid_f(g1[j]) * u1[j]; }
                v4u w; w.x = cvt_pk_bf16(a[0], a[1]); w.y = cvt_pk_bf16(a[2], a[3]); w.z = cvt_pk_bf16(a[4], a[5]); w.w = cvt_pk_bf16(a[6], a[7]);
#if NT_ACT
                __builtin_nontemporal_store(w, (v4u*)p);
#else
                *(v4u*)p = w;
#endif
            }
    }
};
template <bool INB, bool OUTB, bool SUMSQ, bool STORE = true> __device__ __forceinline__ void resid_tile(const void* __restrict__ ibv, void* __restrict__ obv, float* __restrict__ rsum, const pg8::f32x4 (&acc)[2][2][4][2], float scale, int fq) {
    typedef typename std::conditional<INB, bf16, float>::type TI; typedef typename std::conditional<OUTB, bf16, float>::type TO;
    const TI* __restrict__ ib = (const TI*)ibv; TO* __restrict__ ob = (TO*)obv;
    constexpr int NV = INB ? 2 : 4;
    v4u cur[NV], nxt[NV];
#pragma unroll
    for (int q = 0; q < NV; ++q) cur[q] = *(const v4u*)(ib + (INB ? q * 128 : (q >> 1) * 128 + (q & 1) * 4));
#pragma unroll
    for (int g = 0; g < 8; ++g) {
        const size_t off = (size_t)((g >> 2) * 128 + (g & 3) * 16) * DM;
        if (g + 1 < 8) { const size_t offn = (size_t)(((g + 1) >> 2) * 128 + ((g + 1) & 3) * 16) * DM;
#pragma unroll
            for (int q = 0; q < NV; ++q) nxt[q] = *(const v4u*)(ib + offn + (INB ? q * 128 : (q >> 1) * 128 + (q & 1) * 4)); }
        float ss = 0.f;
#pragma unroll
        for (int bj = 0; bj < 2; ++bj) {
            f32x4 r0, r1;
            if constexpr (INB) { const v4u w = cur[bj]; r0 = (f32x4){bf_lo(w.x), bf_hi(w.x), bf_lo(w.y), bf_hi(w.y)}; r1 = (f32x4){bf_lo(w.z), bf_hi(w.z), bf_lo(w.w), bf_hi(w.w)}; }
            else { r0 = __builtin_bit_cast(f32x4, cur[2 * bj]); r1 = __builtin_bit_cast(f32x4, cur[2 * bj + 1]); }
            const f32x4 x0 = r0 + acc[g >> 2][bj][g & 3][0] * scale, x1 = r1 + acc[g >> 2][bj][g & 3][1] * scale;
            if constexpr (SUMSQ) ss += ((x0[0] * x0[0] + x0[1] * x0[1]) + (x0[2] * x0[2] + x0[3] * x0[3])) + ((x1[0] * x1[0] + x1[1] * x1[1]) + (x1[2] * x1[2] + x1[3] * x1[3]));
            if constexpr (!STORE) { }
            else if constexpr (OUTB) { v4u w; w.x = cvt_pk_bf16(x0[0], x0[1]); w.y = cvt_pk_bf16(x0[2], x0[3]); w.z = cvt_pk_bf16(x1[0], x1[1]); w.w = cvt_pk_bf16(x1[2], x1[3]); *(v4u*)(ob + off + bj * 128) = w; }
            else { *(f32x4*)(ob + off + bj * 128) = x0; *(f32x4*)(ob + off + bj * 128 + 4) = x1; }
        }
        if constexpr (SUMSQ) { ss += __shfl_xor(ss, 16); ss += __shfl_xor(ss, 32);
            if (fq == 0) __hip_atomic_fetch_add(rsum + (g >> 2) * 128 + (g & 3) * 16, ss, __ATOMIC_RELAXED, __HIP_MEMORY_SCOPE_AGENT); }
#pragma unroll
        for (int q = 0; q < NV; ++q) cur[q] = nxt[q];
    }
}
template <bool INB, bool OUTB, bool SUMSQ = false> struct EpiResid {
    static constexpr int EPI_ID = 1;
    static constexpr bool DEFER = false;
    static constexpr int NVM = (INB ? 16 : 32) + (OUTB ? 16 : 32) > 48 ? 48 : (INB ? 16 : 32) + (OUTB ? 16 : 32);
    static constexpr bool PERM = true, AFTER_DRAIN = false, HAS_MID = false, HAS_PRE = false;
    const void* in_lo; const void* in_hi; void* out; float scale; float* rowsum;
    __device__ __forceinline__ void operator()(EPI_ARGS) const {
        const int row0 = un.pm * 256 + wr * 64 + fr, col0 = un.pn * 256 + wc * 32 + 8 * fq;
        const size_t off0 = (size_t)row0 * DM + col0;
        const char* ib = (un.pm < MP / 256) ? (const char*)in_lo + off0 * (INB ? 2 : 4) : (const char*)in_hi + (off0 - (size_t)MP * DM) * (INB ? 2 : 4);
        resid_tile<INB, OUTB, SUMSQ>(ib, (char*)out + off0 * (OUTB ? 2 : 4), rowsum + row0, acc, scale, fq);
    }
};
template <bool FROM_X3> __device__ __forceinline__ void final_tile(const void* __restrict__ ibv, float* __restrict__ ob, const float* __restrict__ rsum, const float* __restrict__ gn, const pg8::f32x4 (&acc)[2][2][4][2], float scale) {
    constexpr int NV = FROM_X3 ? 2 : 1;
    typedef typename std::conditional<FROM_X3, float, bf16>::type TI;
    const TI* __restrict__ ib = (const TI*)ibv;
#pragma unroll
    for (int bj = 0; bj < 2; ++bj) {
        const f32x4 g0 = *(const f32x4*)(gn + bj * 128), g1 = *(const f32x4*)(gn + bj * 128 + 4);
        float rcur = __hip_atomic_load(rsum, __ATOMIC_RELAXED, __HIP_MEMORY_SCOPE_AGENT), rnxt = 0.f;
        v4u cur[NV], nxt[NV];
#pragma unroll
        for (int q = 0; q < NV; ++q) cur[q] = *(const v4u*)(ib + bj * 128 + q * 4);
#pragma unroll
        for (int g = 0; g < 8; ++g) {
            if (g + 1 < 8) { const size_t offn = (size_t)(((g + 1) >> 2) * 128 + ((g + 1) & 3) * 16) * DM;
#pragma unroll
                for (int q = 0; q < NV; ++q) nxt[q] = *(const v4u*)(ib + offn + bj * 128 + q * 4);
                rnxt = __hip_atomic_load(rsum + ((g + 1) >> 2) * 128 + ((g + 1) & 3) * 16, __ATOMIC_RELAXED, __HIP_MEMORY_SCOPE_AGENT); }
            const float r = __builtin_amdgcn_rsqf(rcur * (1.0f / DM) + EPS);
            float* o = ob + (size_t)((g >> 2) * 128 + (g & 3) * 16) * DM + bj * 128;
            f32x4 x0, x1;
            if constexpr (FROM_X3) { x0 = __builtin_bit_cast(f32x4, cur[0]); x1 = __builtin_bit_cast(f32x4, cur[1]); }
            else { const v4u w = cur[0];
                x0 = (f32x4){bf_lo(w.x), bf_hi(w.x), bf_lo(w.y), bf_hi(w.y)} + acc[g >> 2][bj][g & 3][0] * scale; x1 = (f32x4){bf_lo(w.z), bf_hi(w.z), bf_lo(w.w), bf_hi(w.w)} + acc[g >> 2][bj][g & 3][1] * scale; }
            __builtin_nontemporal_store(x0 * r * g0, (f32x4*)o); __builtin_nontemporal_store(x1 * r * g1, (f32x4*)(o + 4));
#pragma unroll
            for (int q = 0; q < NV; ++q) cur[q] = nxt[q];
            rcur = rnxt;
        }
    }
}
struct EpiFinal {
    static constexpr int EPI_ID = 1;
    static constexpr bool DEFER = true;
    static constexpr int NVM = 0;
    static constexpr bool PERM = true, AFTER_DRAIN = false, HAS_MID = false, HAS_PRE = false;
    const bf16* in_lo; const bf16* in_hi; float* x3; float* out; const float* gain; float* rowsum; float scale; XcdBarrier bar;
    __device__ __forceinline__ void operator()(EPI_ARGS) const {}
    __device__ __forceinline__ void bar_only() const { xcd_barrier_later(bar); }
    __device__ __forceinline__ void fin(const pg8::f32x4 (&acc)[2][2][4][2], const pg8::Unit& un, int, int, int, int, bool lastu) const {
        int t_ = threadIdx.x; asm volatile("" : "+v"(t_));
        const int wr = t_ >> 8, wc = (t_ >> 6) & 3, fr = t_ & 15, fq = (t_ >> 4) & 3;
        const int row0 = un.pm * 256 + wr * 64 + fr, col0 = un.pn * 256 + wc * 32 + 8 * fq;
        const size_t off0 = (size_t)row0 * DM + col0;
        const bf16* ib = (un.pm < MP / 256) ? in_lo + off0 : in_hi + (off0 - (size_t)MP * DM);
        if (!lastu) resid_tile<true, false, true, true>(ib, x3 + off0, rowsum + row0, acc, scale, fq);
        else {
            resid_tile<true, false, true, false>(ib, x3 + off0, rowsum + row0, acc, scale, fq);
            xcd_barrier_later(bar);
            final_tile<false>(ib, out + off0, rowsum + row0, gain + col0, acc, scale);
        }
    }
    __device__ __forceinline__ void fix(const pg8::f32x4 (&acc)[2][2][4][2], const pg8::Unit& un, int, int, int, int) const {
        int t_ = threadIdx.x; asm volatile("" : "+v"(t_));
        const int wr = t_ >> 8, wc = (t_ >> 6) & 3, fr = t_ & 15, fq = (t_ >> 4) & 3;
        const int row0 = un.pm * 256 + wr * 64 + fr, col0 = un.pn * 256 + wc * 32 + 8 * fq;
        const size_t off0 = (size_t)row0 * DM + col0;
        final_tile<true>(x3 + off0, out + off0, rowsum + row0, gain + col0, acc, scale);
    }
};
__device__ __forceinline__ void resid_norm_tile(const float* __restrict__ ib, float* __restrict__ ob, bf16* __restrict__ hb, float* __restrict__ rsum, const float* __restrict__ gain,
                                                const pg8::f32x4 (&acc)[2][2][4][2], float scale, int fq) {
    f32x4 gv[4];
#pragma unroll
    for (int q = 0; q < 4; ++q) gv[q] = *(const f32x4*)(gain + (q >> 1) * 128 + (q & 1) * 4);
    f32x4 cur[4], nxt[4];
#pragma unroll
    for (int q = 0; q < 4; ++q) cur[q] = *(const f32x4*)(ib + (q >> 1) * 128 + (q & 1) * 4);
#pragma unroll
    for (int g = 0; g < 8; ++g) {
        const int rofs = (g >> 2) * 128 + (g & 3) * 16; const size_t off = (size_t)rofs * DM;
        if (g + 1 < 8) { const size_t offn = (size_t)(((g + 1) >> 2) * 128 + ((g + 1) & 3) * 16) * DM;
#pragma unroll
            for (int q = 0; q < 4; ++q) nxt[q] = *(const f32x4*)(ib + offn + (q >> 1) * 128 + (q & 1) * 4); }
        float ss = 0.f;
#pragma unroll
        for (int bj = 0; bj < 2; ++bj) {
            const f32x4 x0 = cur[2 * bj] + acc[g >> 2][bj][g & 3][0] * scale, x1 = cur[2 * bj + 1] + acc[g >> 2][bj][g & 3][1] * scale;
            *(f32x4*)(ob + off + bj * 128) = x0; *(f32x4*)(ob + off + bj * 128 + 4) = x1;
            ss += ((x0[0] * x0[0] + x0[1] * x0[1]) + (x0[2] * x0[2] + x0[3] * x0[3])) + ((x1[0] * x1[0] + x1[1] * x1[1]) + (x1[2] * x1[2] + x1[3] * x1[3]));
            const f32x4 y0 = x0 * gv[2 * bj], y1 = x1 * gv[2 * bj + 1];
            v4u w; w.x = cvt_pk_bf16(y0[0], y0[1]); w.y = cvt_pk_bf16(y0[2], y0[3]); w.z = cvt_pk_bf16(y1[0], y1[1]); w.w = cvt_pk_bf16(y1[2], y1[3]);
            *(v4u*)(hb + off + bj * 128) = w; }
        ss += __shfl_xor(ss, 16); ss += __shfl_xor(ss, 32);
        if (fq == 0) __hip_atomic_fetch_add(rsum + rofs, ss, __ATOMIC_RELAXED, __HIP_MEMORY_SCOPE_AGENT);
#pragma unroll
        for (int q = 0; q < 4; ++q) cur[q] = nxt[q];
    }
}
struct EpiResidNorm {
    static constexpr int EPI_ID = 1;
    static constexpr bool DEFER = false;
    static constexpr int NVM = 0;
    static constexpr bool PERM = true, AFTER_DRAIN = false, HAS_MID = false, HAS_PRE = false;
    const float* in_lo; const float* in_hi; float* out; float scale; const float* gain; bf16* hraw; float* rowsum;
    __device__ __forceinline__ void operator()(EPI_ARGS) const {
        const int row0 = un.pm * 256 + wr * 64 + fr, col0 = un.pn * 256 + wc * 32 + 8 * fq;
        const float* ib = (un.pm < MP / 256) ? in_lo : in_hi - (size_t)MP * DM;
        const size_t off0 = (size_t)row0 * DM + col0;
        resid_norm_tile(ib + off0, out + off0, hraw + off0, rowsum + row0, gain + col0, acc, scale, fq);
    }
};
template <bool SCALE> struct EpiWin {
    static constexpr int EPI_ID = 2;
    static constexpr bool DEFER = false;
    static constexpr int NVM = 16;
    static constexpr bool PERM = false, AFTER_DRAIN = false, HAS_MID = false, HAS_PRE = SCALE;
    __device__ __forceinline__ void pre(float (&p)[8], const pg8::Unit& un, int wr, int fr) const {
        int ro = wr * 64 + fr; asm volatile("" : "+v"(ro));
        const float* r = rowsum + un.pm * 256 + ro;
        PRE_LOAD(p[0], r, 0); PRE_LOAD(p[1], r, 64); PRE_LOAD(p[2], r, 128); PRE_LOAD(p[3], r, 192); PRE_LOAD(p[4], r, 512); PRE_LOAD(p[5], r, 576); PRE_LOAD(p[6], r, 640); PRE_LOAD(p[7], r, 704); }
    bf16 *QA, *KA, *VA, *QB, *KB, *VB, *SGA, *SGB; float* out; const float* rcos; const float* rsin; const float* rowsum;
    __device__ __forceinline__ void operator()(EPI_ARGS) const {
        const int reg = un.pn >> 2;
        const bool smp = un.pm >= MP / 256;
        const int row0 = un.pm * 256 + wr * 64 + fr;
        float rs[2][4];
#pragma unroll
        for (int ai = 0; ai < 2; ++ai)
#pragma unroll
            for (int m = 0; m < 4; ++m) rs[ai][m] = SCALE ? __builtin_amdgcn_rsqf(pre[ai * 4 + m] * (1.0f / DM) + EPS) : 1.0f;
        if (reg < 2) {
            const int cl = 64 * (4 * (un.pn & 3) + wc) + 8 * fq;
#pragma unroll
            for (int ai = 0; ai < 2; ++ai) {
                f32x4 cs[4][2][2];
#pragma unroll
                for (int m = 0; m < 4; ++m) { const int row = row0 + ai * 128 + m * 16; const int pos = smp ? 2048 + ((row - MP) & 63) : (row & 4095);
#pragma unroll
                    for (int n = 0; n < 2; ++n) { cs[m][n][0] = *(const f32x4*)(rcos + pos * 32 + 8 * fq + 4 * n); cs[m][n][1] = *(const f32x4*)(rsin + pos * 32 + 8 * fq + 4 * n); } }
                asm volatile("" :: "v"(cs[0][0][0]), "v"(cs[0][0][1]), "v"(cs[0][1][0]), "v"(cs[0][1][1]), "v"(cs[1][0][0]), "v"(cs[1][0][1]), "v"(cs[1][1][0]), "v"(cs[1][1][1]),
                                  "v"(cs[2][0][0]), "v"(cs[2][0][1]), "v"(cs[2][1][0]), "v"(cs[2][1][1]), "v"(cs[3][0][0]), "v"(cs[3][0][1]), "v"(cs[3][1][0]), "v"(cs[3][1][1]) : "memory");
#pragma unroll
                for (int m = 0; m < 4; ++m) {
                    const int row = row0 + ai * 128 + m * 16;
                    f32x4 o1[2], o2[2];
#pragma unroll
                    for (int n = 0; n < 2; ++n) {
                        const f32x4 c = cs[m][n][0], s = cs[m][n][1];
                        const f32x4 x1 = acc[ai][0][m][n] * rs[ai][m], x2 = acc[ai][1][m][n] * rs[ai][m];
                        o1[n] = x1 * c - x2 * s; o2[n] = x2 * c + x1 * s;
                        if (reg == 0) { o1[n] = o1[n] * QS_A; o2[n] = o2[n] * QS_A; }
                    }
                    v4u w1, w2; w1.x = cvt_pk_bf16(o1[0][0], o1[0][1]); w1.y = cvt_pk_bf16(o1[0][2], o1[0][3]); w1.z = cvt_pk_bf16(o1[1][0], o1[1][1]); w1.w = cvt_pk_bf16(o1[1][2], o1[1][3]);
                    w2.x = cvt_pk_bf16(o2[0][0], o2[0][1]); w2.y = cvt_pk_bf16(o2[0][2], o2[0][3]); w2.z = cvt_pk_bf16(o2[1][0], o2[1][1]); w2.w = cvt_pk_bf16(o2[1][2], o2[1][3]);
                    bf16* qk = (reg == 0 ? QA : KA) + (size_t)row * 1024 + cl;
                    *(v4u*)qk = w1; *(v4u*)(qk + 32) = w2;
                    if (reg == 1) {
                        float* ob = (smp ? out + OFF_AKS + (size_t)(row - MP) * 1024 : out + OFF_AKP + (size_t)row * 1024) + cl;
                        __builtin_nontemporal_store(o1[0], (f32x4*)ob); __builtin_nontemporal_store(o1[1], (f32x4*)(ob + 4));
                        __builtin_nontemporal_store(o2[0], (f32x4*)(ob + 32)); __builtin_nontemporal_store(o2[1], (f32x4*)(ob + 36));
                    }
                }
            }
        } else {
            const int rstart = reg < 6 ? reg * 1024 : (reg < 8 ? 6144 : 8192);
            const int cl0 = un.pn * 256 - rstart + wc * 32 + 8 * fq;
            const bool band = smp || ((un.pm & 15) >= 14);
#pragma unroll
            for (int ai = 0; ai < 2; ++ai)
#pragma unroll
                for (int m = 0; m < 4; ++m) {
                    const int row = row0 + ai * 128 + m * 16;
                    size_t brow;
                    if (smp) { const int rr = row - MP; brow = (size_t)(rr >> 6) * 512 + 448 + (rr & 63); }
                    else { const int bb = row >> 12; brow = (size_t)bb * 512 + ((row & 4095) - 3584); }
#pragma unroll
                    for (int bj = 0; bj < 2; ++bj) {
                        const int cl = cl0 + bj * 128;
                        f32x4 v0 = acc[ai][bj][m][0] * rs[ai][m], v1 = acc[ai][bj][m][1] * rs[ai][m];
                        if (reg == 2) {
                            float* ob = (smp ? out + OFF_AVS + (size_t)(row - MP) * 1024 : out + OFF_AVP + (size_t)row * 1024) + cl;
                            __builtin_nontemporal_store(v0, (f32x4*)ob); __builtin_nontemporal_store(v1, (f32x4*)(ob + 4));
                        } else if (reg == 4 || reg == 5) {
                            if (band) { float* ob = out + (reg == 4 ? (smp ? OFF_BKS : OFF_BKP) : (smp ? OFF_BVS : OFF_BVP)) + brow * 1024 + cl; __builtin_nontemporal_store(v0, (f32x4*)ob); __builtin_nontemporal_store(v1, (f32x4*)(ob + 4)); }
                        } else if (reg == 3) { v0 = v0 * QS_B; v1 = v1 * QS_B; }
                        else {
#pragma unroll
                            for (int j = 0; j < 4; ++j) { v0[j] = sigmoid_f(v0[j]); v1[j] = sigmoid_f(v1[j]); }
                        }
                        v4u w; w.x = cvt_pk_bf16(v0[0], v0[1]); w.y = cvt_pk_bf16(v0[2], v0[3]); w.z = cvt_pk_bf16(v1[0], v1[1]); w.w = cvt_pk_bf16(v1[2], v1[3]);
                        bf16* dst;
                        if (reg < 6) dst = (reg == 2 ? VA : reg == 3 ? QB : reg == 4 ? KB : VB) + (size_t)row * 1024 + cl;
                        else dst = (reg < 8 ? SGA : SGB) + (size_t)row * DM + cl;
                        *(v4u*)dst = w;
                    }
                }
        }
    }
};
struct EpiMerge {
    static constexpr int EPI_ID = 3;
    static constexpr bool DEFER = false;
    static constexpr int NVM = 32;
    static constexpr bool PERM = true, AFTER_DRAIN = false, HAS_MID = true, HAS_PRE = false; static constexpr int KMID = 16;
    const bf16* SGA; const bf16* SGB; bf16* O;
    __device__ __forceinline__ void mid(pg8::f32x4 (&acc)[2][2][4][2], const pg8::Unit& un, int wr, int wc, int fr, int fq) const {
        int row0 = un.pm * 256 + wr * 64 + fr, col0 = un.pn * 256 + wc * 32 + 8 * fq;
        asm volatile("" : "+v"(row0), "+v"(col0));
#pragma unroll
        for (int ai = 0; ai < 2; ++ai) {
            v4u a[8], b[8];
#pragma unroll
            for (int e = 0; e < 8; ++e) { const size_t off = (size_t)(row0 + ai * 128 + (e >> 1) * 16) * DM + col0 + (e & 1) * 128; a[e] = *(const v4u*)(SGA + off); b[e] = *(const v4u*)(SGB + off); }
            asm volatile("" :: "v"(a[0]), "v"(a[1]), "v"(a[2]), "v"(a[3]), "v"(a[4]), "v"(a[5]), "v"(a[6]), "v"(a[7]), "v"(b[0]), "v"(b[1]), "v"(b[2]), "v"(b[3]), "v"(b[4]), "v"(b[5]), "v"(b[6]), "v"(b[7]) : "memory");
#pragma unroll
            for (int e = 0; e < 8; ++e) { const int m = e >> 1, bj = e & 1;
                f32x4 r0, r1;
                r0[0] = bf_lo(a[e].x) * __builtin_amdgcn_rcpf(bf_lo(b[e].x)); r0[1] = bf_hi(a[e].x) * __builtin_amdgcn_rcpf(bf_hi(b[e].x));
                r0[2] = bf_lo(a[e].y) * __builtin_amdgcn_rcpf(bf_lo(b[e].y)); r0[3] = bf_hi(a[e].y) * __builtin_amdgcn_rcpf(bf_hi(b[e].y));
                r1[0] = bf_lo(a[e].z) * __builtin_amdgcn_rcpf(bf_lo(b[e].z)); r1[1] = bf_hi(a[e].z) * __builtin_amdgcn_rcpf(bf_hi(b[e].z));
                r1[2] = bf_lo(a[e].w) * __builtin_amdgcn_rcpf(bf_lo(b[e].w)); r1[3] = bf_hi(a[e].w) * __builtin_amdgcn_rcpf(bf_hi(b[e].w));
                acc[ai][bj][m][0] = acc[ai][bj][m][0] * r0; acc[ai][bj][m][1] = acc[ai][bj][m][1] * r1; }
        }
    }
    __device__ __forceinline__ void operator()(EPI_ARGS) const {
        const int row0 = un.pm * 256 + wr * 64 + fr, col0 = un.pn * 256 + wc * 32 + 8 * fq;
        v4u b[16];
#pragma unroll
        for (int e = 0; e < 16; ++e) b[e] = *(const v4u*)(SGB + (size_t)(row0 + (e >> 3) * 128 + ((e >> 1) & 3) * 16) * DM + col0 + (e & 1) * 128);
        asm volatile("" :: "v"(b[0]), "v"(b[1]), "v"(b[2]), "v"(b[3]), "v"(b[4]), "v"(b[5]), "v"(b[6]), "v"(b[7]), "v"(b[8]), "v"(b[9]), "v"(b[10]), "v"(b[11]), "v"(b[12]), "v"(b[13]), "v"(b[14]), "v"(b[15]) : "memory");
#pragma unroll
        for (int e = 0; e < 16; ++e) { const int ai = e >> 3, m = (e >> 1) & 3, bj = e & 1;
            const size_t off = (size_t)(row0 + ai * 128 + m * 16) * DM + col0 + bj * 128;
            const f32x4 v0 = acc[ai][bj][m][0], v1 = acc[ai][bj][m][1];
            v4u w; w.x = cvt_pk_bf16(v0[0] * bf_lo(b[e].x), v0[1] * bf_hi(b[e].x)); w.y = cvt_pk_bf16(v0[2] * bf_lo(b[e].y), v0[3] * bf_hi(b[e].y));
            w.z = cvt_pk_bf16(v1[0] * bf_lo(b[e].z), v1[1] * bf_hi(b[e].z)); w.w = cvt_pk_bf16(v1[2] * bf_lo(b[e].w), v1[3] * bf_hi(b[e].w));
            *(v4u*)(O + off) = w; }
    }
};
__device__ __forceinline__ int perm32inv(int c) { return 16 * ((c >> 2) & 1) + 4 * (c >> 3) + (c & 3); }
template <int MAP> __device__ __forceinline__ int rowmap(int n) {
    if constexpr (MAP == 1) return 256 * (n >> 7) + (n & 127);
    else if constexpr (MAP == 2) return 256 * (n >> 7) + 128 + (n & 127);
    else if constexpr (MAP == 3) { if (n >= 2048) return (n & ~31) + perm32inv(n & 31);
        const int l = n & 255, i = l & 31; return (n & ~255) + 128 * ((l >> 5) & 1) + 32 * (l >> 6) + 16 * ((i >> 2) & 1) + 4 * (i >> 3) + (i & 3); }
    else return n;
}
#ifdef TR_OLD
template <int MAP> __device__ __forceinline__ void tr_item(const float* W, int N, bf16* WT, int Kd, int koff, LAS float* scr, int item, int lane) {
    const int nblk = N / 32, kb = item / nblk, nb = item % nblk, k0 = 64 * kb, n0 = 32 * nb;
#pragma unroll 8
    for (int i = 0; i < 32; ++i) { const int kk = 2 * i + (lane >> 5); scr[kk * 33 + (lane & 31)] = W[(size_t)(k0 + kk) * N + n0 + (lane & 31)]; }
    LDS_WAIT(); asm volatile("" ::: "memory");
    const int c = lane & 7;
#pragma unroll
    for (int j = 0; j < 4; ++j) { const int n = (lane >> 3) + 8 * j; const LAS float* s = scr + (8 * c) * 33 + n;
        v4u o; o.x = pk2(s[0 * 33], s[1 * 33]); o.y = pk2(s[2 * 33], s[3 * 33]); o.z = pk2(s[4 * 33], s[5 * 33]); o.w = pk2(s[6 * 33], s[7 * 33]);
        *(GAS v4u*)(WT + (size_t)rowmap<MAP>(n0 + n) * Kd + koff + k0 + 8 * c) = o; }
    LDS_WAIT(); asm volatile("" ::: "memory");
}
#else
template <int MAP> __device__ __forceinline__ void tr_item(const float* W, int N, bf16* WT, int Kd, int koff, LAS float* scr, int item, int lane, const float* g = nullptr) {
    const int nblk = N / 32, kb = item / nblk, nb = item % nblk, k0 = 64 * kb, n0 = 32 * nb;
    const int kr = lane >> 3, nq = lane & 7;
    f32x4 v[8];
#pragma unroll
    for (int i = 0; i < 8; ++i) v[i] = __builtin_nontemporal_load((const GAS f32x4*)(W + (size_t)(k0 + 8 * i + kr) * N + n0 + 4 * nq));
#pragma unroll
    for (int i = 0; i < 8; ++i) { LAS float* d = scr + (8 * i + kr) * 33 + 4 * nq; d[0] = v[i].x; d[1] = v[i].y; d[2] = v[i].z; d[3] = v[i].w; }
    LDS_WAIT(); asm volatile("" ::: "memory");
    const int c = lane >> 3, n8 = lane & 7;
    f32x4 ga = (f32x4){1.f, 1.f, 1.f, 1.f}, gb = ga; if (g) { ga = *(const f32x4*)(g + k0 + 8 * c); gb = *(const f32x4*)(g + k0 + 8 * c + 4); }
#pragma unroll
    for (int j = 0; j < 4; ++j) { const int n = n8 + 8 * j; const LAS float* s = scr + (8 * c) * 33 + n;
        v4u o; o.x = pk2(s[0 * 33] * ga[0], s[1 * 33] * ga[1]); o.y = pk2(s[2 * 33] * ga[2], s[3 * 33] * ga[3]); o.z = pk2(s[4 * 33] * gb[0], s[5 * 33] * gb[1]); o.w = pk2(s[6 * 33] * gb[2], s[7 * 33] * gb[3]);
        *(GAS v4u*)(WT + (size_t)rowmap<MAP>(n0 + n) * Kd + koff + k0 + 8 * c) = o; }
    LDS_WAIT(); asm volatile("" ::: "memory");
}
#endif
struct TrDesc { const float* W; bf16* WT; const float* g; int N, Kd, koff, map, it; };
__device__ __forceinline__ int rowmap_rt(int map, int n) { return map == 1 ? rowmap<1>(n) : map == 2 ? rowmap<2>(n) : map == 3 ? rowmap<3>(n) : n; }
__device__ __forceinline__ TrDesc tr_desc(int j, int gw, const float* const* in, unsigned char* ws) {
    TrDesc d; d.koff = 0; d.map = 0; d.g = nullptr;
    if (j < 12) { const int q = j & 3, w = j >> 2; d.W = in[w == 0 ? 22 : w == 1 ? 23 : 24]; d.WT = (bf16*)(ws + (w == 2 ? WS_W2D : WS_W2)); d.N = w == 2 ? DM : FF; d.Kd = w == 2 ? FF : DM; d.map = w == 2 ? 0 : w + 1; d.it = gw + q * 2048; if (NORM_FOLD && w != 2) d.g = in[21]; }
    else if (j == 12) { d.W = in[20]; d.WT = (bf16*)(ws + WS_WOUT); d.N = DM; d.Kd = DM; d.it = gw; }
    else if (j == 13) { const bool second = gw >= 1024; d.W = in[second ? 19 : 18]; d.WT = (bf16*)(ws + WS_WBR); d.N = DM; d.Kd = DM; d.koff = second ? 1024 : 0; d.it = second ? gw - 1024 : gw; }
    else if (j < 19) { d.W = in[11]; d.WT = (bf16*)(ws + WS_WIN); d.N = NIN; d.Kd = DM; d.map = 3; d.it = gw + (j - 14) * 2048; if (NORM_FOLD) d.g = in[10]; }
    else { const int jj = j - 19, q = jj & 3, w = jj >> 2; d.W = in[w == 0 ? 9 : w == 1 ? 7 : 8]; d.WT = (bf16*)(ws + (w == 0 ? WS_W1D : WS_W1)); d.N = w == 0 ? DM : FF; d.Kd = w == 0 ? FF : DM; d.map = w; d.it = gw + q * 2048; }
    return d;
}
#define TR_LOAD(v, d) do { const int nblk_ = (d).N / 32, k0_ = 64 * ((d).it / nblk_), n0_ = 32 * ((d).it % nblk_); \
        _Pragma("unroll") for (int i_ = 0; i_ < 8; ++i_) v[i_] = __builtin_nontemporal_load((const GAS f32x4*)((d).W + (size_t)(k0_ + 8 * i_ + kr) * (d).N + n0_ + 4 * nq)); } while (0)
#define TR_TO_LDS(v) do { _Pragma("unroll") for (int i_ = 0; i_ < 8; ++i_) { LAS float* d_ = scr + (8 * i_ + kr) * 33 + 4 * nq; d_[0] = v[i_].x; d_[1] = v[i_].y; d_[2] = v[i_].z; d_[3] = v[i_].w; } \
        LDS_WAIT(); asm volatile("" ::: "memory"); } while (0)
#define TR_G(d) do { if ((d).g) { const int nblk_ = (d).N / 32, k0_ = 64 * ((d).it / nblk_); ga_ = *(const GAS f32x4*)((d).g + k0_ + 8 * c); gb_ = *(const GAS f32x4*)((d).g + k0_ + 8 * c + 4); } \
        else { ga_ = (f32x4){1.f, 1.f, 1.f, 1.f}; gb_ = ga_; } } while (0)
#define TR_OUT(d) do { const int nblk_ = (d).N / 32, k0_ = 64 * ((d).it / nblk_), n0_ = 32 * ((d).it % nblk_); \
        _Pragma("unroll") for (int j_ = 0; j_ < 4; ++j_) { const int n_ = n8 + 8 * j_; const LAS float* s_ = scr + (8 * c) * 33 + n_; \
            v4u o_; o_.x = pk2(s_[0 * 33] * ga_[0], s_[1 * 33] * ga_[1]); o_.y = pk2(s_[2 * 33] * ga_[2], s_[3 * 33] * ga_[3]); o_.z = pk2(s_[4 * 33] * gb_[0], s_[5 * 33] * gb_[1]); o_.w = pk2(s_[6 * 33] * gb_[2], s_[7 * 33] * gb_[3]); \
            GAS bf16* p_ = (GAS bf16*)((d).WT + (size_t)rowmap_rt((d).map, n0_ + n_) * (d).Kd + (d).koff + k0_ + 8 * c); \
            asm volatile("global_store_dwordx4 %0, %1, off\n\ts_nop 1" :: "v"(p_), "v"(o_) : "memory"); }     \
        LDS_WAIT(); asm volatile("" ::: "memory"); } while (0)
__device__ __forceinline__ TrDesc tr_desc_ffn2(int id, const float* const* in, unsigned char* ws) {
    TrDesc d; d.koff = 0; d.g = nullptr;
    if (id < 8192) { d.W = in[22]; d.WT = (bf16*)(ws + WS_W2); d.N = FF; d.Kd = DM; d.map = 1; d.it = id; if (NORM_FOLD) d.g = in[21]; }
    else if (id < 16384) { d.W = in[23]; d.WT = (bf16*)(ws + WS_W2); d.N = FF; d.Kd = DM; d.map = 2; d.it = id - 8192; if (NORM_FOLD) d.g = in[21]; }
    else { d.W = in[24]; d.WT = (bf16*)(ws + WS_W2D); d.N = DM; d.Kd = FF; d.map = 0; d.it = id - 16384; }
    return d;
}
__device__ __forceinline__ void p0_convert_stream(const float* const* in, unsigned char* ws, LAS float* scr, int gw, int lane, int j0  ) {
    const int kr = lane >> 3, nq = lane & 7, c = lane >> 3, n8 = lane & 7;
    f32x4 vA[8], vB[8], ga_, gb_;
    { const TrDesc d0 = tr_desc(j0, gw, in, ws), d1 = tr_desc(j0 + 1, gw, in, ws); TR_LOAD(vA, d0); TR_LOAD(vB, d1); }
    for (int j = j0; j < 30; j += 2) {
        { const TrDesc d = tr_desc(j, gw, in, ws), dn = tr_desc(j + 2, gw, in, ws); TR_TO_LDS(vA); TR_G(d); TR_LOAD(vA, dn); TR_OUT(d); }
        { const TrDesc d = tr_desc(j + 1, gw, in, ws), dn = tr_desc(j + 3 < 31 ? j + 3 : 30, gw, in, ws); TR_TO_LDS(vB); TR_G(d); TR_LOAD(vB, dn); TR_OUT(d); }
    }
    { const TrDesc d = tr_desc(30, gw, in, ws); TR_TO_LDS(vA); TR_G(d); TR_OUT(d); }
    asm volatile("s_waitcnt vmcnt(0)" ::: "memory");
}

#ifndef ATT_ROT
#define ATT_ROT 0
#endif
#ifndef ATT_SIMPLE0
#define ATT_SIMPLE0 0
#endif
#ifndef ATT_L3
#define ATT_L3 0
#endif
#ifndef CONV_L2
#define CONV_L2 1
#endif
namespace att {
typedef short bf16x8 __attribute__((ext_vector_type(8)));
typedef short s16x4 __attribute__((ext_vector_type(4)));
typedef float f32x16 __attribute__((ext_vector_type(16)));
typedef float f32x8 __attribute__((ext_vector_type(8)));
typedef unsigned u32x4 __attribute__((ext_vector_type(4)));
typedef unsigned u32x2l __attribute__((ext_vector_type(2)));
#define ATT_LAS __attribute__((address_space(3)))
#define KSWZ(row, colB) ((row) * 256 + ((colB) ^ (((row) & 7) << 4)))
#define SBAR() __builtin_amdgcn_sched_barrier(0)
constexpr float THR = 6.f;
__device__ __forceinline__ int crow(int r, int hi) { return (r & 3) + 8 * (r >> 2) + 4 * hi; }
__device__ __forceinline__ unsigned cvtpk(float lo, float hi) { unsigned r; asm volatile("v_cvt_pk_bf16_f32 %0, %1, %2" : "=v"(r) : "v"(lo), "v"(hi)); return r; }
template <typename TIn> struct Stage;
template <> struct Stage<unsigned short> { using T = bf16x8;
    __device__ static __forceinline__ T ld8(const unsigned short* p) { return *reinterpret_cast<const bf16x8*>(p); }
    __device__ static __forceinline__ bf16x8 tobf(T x) { return x; } };
template <> struct Stage<float> { using T = f32x8;
    __device__ static __forceinline__ T ld8(const float* p) { return *reinterpret_cast<const f32x8*>(p); }
    __device__ static __forceinline__ bf16x8 tobf(T x) { u32x4 w = {cvtpk(x[0], x[1]), cvtpk(x[2], x[3]), cvtpk(x[4], x[5]), cvtpk(x[6], x[7])}; return __builtin_bit_cast(bf16x8, w); } };

__device__ __forceinline__ void partialSM(f32x16& p0, f32x16& p1, float& m_reg, float& alpha) {
    float pmax = p0[0];
#pragma unroll
    for (int r = 1; r < 16; ++r) pmax = fmaxf(pmax, p0[r]);
#pragma unroll
    for (int r = 0; r < 16; ++r) pmax = fmaxf(pmax, p1[r]);
    { auto rr = __builtin_amdgcn_permlane32_swap(__float_as_uint(pmax), __float_as_uint(pmax), false, false); pmax = fmaxf(__uint_as_float(rr[0]), __uint_as_float(rr[1])); }
    float mn;
    if (__builtin_expect(__all(pmax - m_reg <= THR), 1)) { mn = m_reg; alpha = 1.f; }
    else { mn = fmaxf(m_reg, pmax); alpha = __builtin_amdgcn_exp2f(m_reg - mn); m_reg = mn; }
#pragma unroll
    for (int r = 0; r < 16; ++r) { p0[r] = p0[r] - mn; p1[r] = p1[r] - mn; }
#pragma unroll
    for (int r = 0; r < 16; ++r) p0[r] = __builtin_amdgcn_exp2f(p0[r]);
}
__device__ __forceinline__ void finishSM(f32x16& p0, f32x16& p1, float alpha, float& l_reg, bf16x8& pa0, bf16x8& pa1, bf16x8& pa2, bf16x8& pa3) {
#pragma unroll
    for (int r = 0; r < 16; ++r) p1[r] = __builtin_amdgcn_exp2f(p1[r]);
    float ps = 0;
#pragma unroll
    for (int r = 0; r < 16; ++r) ps += p0[r];
#pragma unroll
    for (int r = 0; r < 16; ++r) ps += p1[r];
    { auto rr = __builtin_amdgcn_permlane32_swap(__float_as_uint(ps), __float_as_uint(ps), false, false); ps = __uint_as_float(rr[0]) + __uint_as_float(rr[1]); }
    l_reg = l_reg * alpha + ps;
#define PK4(P, BASE, OUT) do { unsigned a0 = cvtpk(P[BASE + 0], P[BASE + 1]), a1 = cvtpk(P[BASE + 2], P[BASE + 3]);   \
    unsigned b0 = cvtpk(P[BASE + 4], P[BASE + 5]), b1 = cvtpk(P[BASE + 6], P[BASE + 7]);                              \
    auto r0 = __builtin_amdgcn_permlane32_swap(a0, b0, false, false); auto r1 = __builtin_amdgcn_permlane32_swap(a1, b1, false, false); \
    u32x4 w = {r0[0], r1[0], r0[1], r1[1]}; OUT = __builtin_bit_cast(bf16x8, w); } while (0)
    PK4(p0, 0, pa0); PK4(p0, 8, pa1); PK4(p1, 0, pa2); PK4(p1, 8, pa3);
#undef PK4
}
template <int NQ> __device__ __forceinline__ void qkt(f32x16& p0, f32x16& p1, const ATT_LAS char* Ks, const bf16x8* qr, int d0b, int r32, int hi) {
    p0 = f32x16{}; p1 = f32x16{};
#pragma unroll
    for (int d = 0; d < NQ; ++d) { const int cb = ((d0b + d) * 16 + hi * 8) * 2;
        const bf16x8 b0 = *reinterpret_cast<const ATT_LAS bf16x8*>(Ks + KSWZ(r32, cb));
        const bf16x8 b1 = *reinterpret_cast<const ATT_LAS bf16x8*>(Ks + KSWZ(32 + r32, cb));
        p0 = __builtin_amdgcn_mfma_f32_32x32x16_bf16(b0, qr[d], p0, 0, 0, 0);
        p1 = __builtin_amdgcn_mfma_f32_32x32x16_bf16(b1, qr[d], p1, 0, 0, 0); }
}
__device__ __forceinline__ int v_st(int k, int c) { const int kk = (k & ~0xC) | ((k & 4) << 1) | ((k & 8) >> 1); return ((kk >> 3) * 4 + (c >> 5)) * 512 + ((kk & 7) * 32 + (c & 31)) * 2; }
__device__ __forceinline__ int v_rd_base(int lane) { return ((lane & 3) << 3) | (((lane >> 2) & 3) << 6) | (((lane >> 4) & 1) << 5) | (((lane >> 5) & 1) << 8); }
constexpr int v_rd_off(int d0, int ks, int half) { return d0 * 512 + ks * 4096 + half * 2048; }
template <int OFF> __device__ __forceinline__ s16x4 tr_read(int vb) { s16x4 r; asm volatile("ds_read_b64_tr_b16 %0, %1 offset:%2" : "=&v"(r) : "v"(vb), "i"(OFF) : "memory"); return r; }
template <int KS> __device__ __forceinline__ void pv_step(f32x16* o, int vb, bf16x8 pa) {
    const s16x4 l0 = tr_read<v_rd_off(0, KS, 0)>(vb), h0 = tr_read<v_rd_off(0, KS, 1)>(vb), l1 = tr_read<v_rd_off(1, KS, 0)>(vb), h1 = tr_read<v_rd_off(1, KS, 1)>(vb);
    const s16x4 l2 = tr_read<v_rd_off(2, KS, 0)>(vb), h2 = tr_read<v_rd_off(2, KS, 1)>(vb), l3 = tr_read<v_rd_off(3, KS, 0)>(vb), h3 = tr_read<v_rd_off(3, KS, 1)>(vb);
    asm volatile("s_waitcnt lgkmcnt(0)" ::: "memory"); SBAR();
#define PKV(L, H) (bf16x8){L[0], L[1], L[2], L[3], H[0], H[1], H[2], H[3]}
    o[0] = __builtin_amdgcn_mfma_f32_32x32x16_bf16(pa, PKV(l0, h0), o[0], 0, 0, 0);
    o[1] = __builtin_amdgcn_mfma_f32_32x32x16_bf16(pa, PKV(l1, h1), o[1], 0, 0, 0);
    o[2] = __builtin_amdgcn_mfma_f32_32x32x16_bf16(pa, PKV(l2, h2), o[2], 0, 0, 0);
    o[3] = __builtin_amdgcn_mfma_f32_32x32x16_bf16(pa, PKV(l3, h3), o[3], 0, 0, 0);
#undef PKV
}
__device__ __forceinline__ void pv_d0(f32x16* o, int vb, bf16x8 pa0, bf16x8 pa1, bf16x8 pa2, bf16x8 pa3) {
    pv_step<0>(o, vb, pa0); pv_step<1>(o, vb, pa1); pv_step<2>(o, vb, pa2); pv_step<3>(o, vb, pa3);
}
struct AttnP { const bf16 *QA, *KA, *VA, *QB, *KB, *VB; bf16* OAB; const float *cak, *cav, *cbk, *cbv; float* out; const float* relb; const float* subln; float* dummy; float lam; const float* const* in; unsigned char* wsb; int conv_on; };

template <int KIND> __device__ __forceinline__ void attn_unit(const AttnP& P, const int u, ATT_LAS char* lds) {
    constexpr bool IS_A = KIND < 2, IS_S = (KIND & 1) != 0;
    constexpr int NQ = IS_A ? 4 : 8, SDEPTH = (KIND == 0 && !ATT_SIMPLE0) ? 2 : 1;
    using TS = typename std::conditional<IS_S, float, unsigned short>::type;
    using St = Stage<TS>;
    const int tid = threadIdx.x, wid = __builtin_amdgcn_readfirstlane(tid >> 6), lane = tid & 63, r32 = lane & 31, hi = lane >> 5;
    ATT_LAS char* V_lds = lds; ATT_LAS char* K_lds = lds + 32768;
    ATT_LAS float* wsc = (ATT_LAS float*)(lds + 65536) + wid * 64; ATT_LAS float* li_l = wsc; ATT_LAS float* al_l = wsc + 32;
    ATT_LAS float* tab = (ATT_LAS float*)(lds + 65536 + 2048);
    int h, NT, tsplit, map = 0, pslot = 0, cw = 0, kc0 = 0, qrow; bool active = true, lastmask = false;
    const bf16* Qw; const TS *Kt0, *Kt1, *Vt0, *Vt1;
    float* okb = nullptr; float* ovb = nullptr;
    if constexpr (KIND == 0) {
        const int qt = u & 31, b = u >> 8; h = (u >> 5) & 7; map = wid >> 2; pslot = wid & 3;
        qrow = b * 4096 + qt * 128 + pslot * 32; Qw = P.QA + (size_t)qrow * 1024 + h * 128 + map * 64;
        Kt0 = Kt1 = (const TS*)(P.KA + (size_t)b * 4096 * 1024 + h * 128); Vt0 = Vt1 = (const TS*)(P.VA + (size_t)b * 4096 * 1024 + h * 128);
        NT = 2 * qt + 2; tsplit = NT; lastmask = pslot < 2;
    } else if constexpr (KIND == 1) {
        const int b = u >> 3; h = u & 7; active = wid < 4; map = (wid >> 1) & 1; pslot = wid & 1;
        qrow = MP + b * 64 + pslot * 32; Qw = P.QA + (size_t)qrow * 1024 + h * 128 + map * 64;
        Kt0 = (const TS*)(P.cak + ((size_t)b * 2048 * 8 + h) * 128); Vt0 = (const TS*)(P.cav + ((size_t)b * 2048 * 8 + h) * 128);
        Kt1 = (const TS*)(P.out + OFF_AKS + ((size_t)b * 64 * 8 + h) * 128); Vt1 = (const TS*)(P.out + OFF_AVS + ((size_t)b * 64 * 8 + h) * 128);
        NT = 34; tsplit = 32;
    } else if constexpr (KIND == 2) {
        const int qg = u & 15, b = u >> 7; h = (u >> 4) & 7; const int c0 = 4 * qg; cw = c0 + (wid >> 1);
        qrow = b * 4096 + cw * 64 + (wid & 1) * 32; Qw = P.QB + (size_t)qrow * 1024 + h * 128;
        kc0 = c0 > 8 ? c0 - 8 : 0; NT = c0 + 4 - kc0; tsplit = NT;
        Kt0 = Kt1 = (const TS*)(P.KB + ((size_t)b * 4096 + kc0 * 64) * 1024 + h * 128); Vt0 = Vt1 = (const TS*)(P.VB + ((size_t)b * 4096 + kc0 * 64) * 1024 + h * 128);
    } else {
        const int b = u >> 3; h = u & 7; active = wid < 2; cw = 8;
        qrow = MP + b * 64 + (wid & 1) * 32; Qw = P.QB + (size_t)qrow * 1024 + h * 128;
        Kt0 = (const TS*)(P.cbk + ((size_t)b * 512 * 8 + h) * 128); Vt0 = (const TS*)(P.cbv + ((size_t)b * 512 * 8 + h) * 128);
        Kt1 = (const TS*)(P.out + OFF_BKS + (((size_t)b * 512 + 448) * 8 + h) * 128); Vt1 = (const TS*)(P.out + OFF_BVS + (((size_t)b * 512 + 448) * 8 + h) * 128);
        okb = P.out + OFF_BKS + ((size_t)b * 512 * 8 + h) * 128; ovb = P.out + OFF_BVS + ((size_t)b * 512 * 8 + h) * 128;
        NT = 10; tsplit = 8;
    }
    const int d0b = IS_A ? 4 * map : 0;
    const int qi = 32 * (wid & 1) + r32;
    float c256 = 0.f;
    if constexpr (!IS_A) { if (tid < 257) tab[tid] = P.relb[h * 257 + tid] * LOG2E; c256 = P.relb[h * 257 + 256] * LOG2E; }
    float m_reg = -1e30f, l_reg = 0.f; f32x16 o[4]; bf16x8 qr[NQ];
    if constexpr (!IS_S) { o[0] = f32x16{}; o[1] = f32x16{}; o[2] = f32x16{}; o[3] = f32x16{}; }
    if constexpr (!IS_S) {
#pragma unroll
        for (int d = 0; d < NQ; ++d) qr[d] = *reinterpret_cast<const bf16x8*>(Qw + (size_t)r32 * 1024 + d * 16 + hi * 8);
    }
    const int sr = tid >> 4, sc = (tid & 15) * 8, vst0 = v_st(sr, sc), vst1 = v_st(32 + sr, sc);
    const int vb0 = (int)(unsigned)(uintptr_t)V_lds + v_rd_base(lane);
    struct { typename St::T vs0, vs1, ks0, ks1; } sr_[SDEPTH];
#define SLOAD(i, t) do { if (!IS_S || (t) <= tsplit) { const TS* kb_ = ((t) < tsplit) ? Kt0 + (size_t)(t) * 65536 : Kt1; const TS* vb_ = ((t) < tsplit) ? Vt0 + (size_t)(t) * 65536 : Vt1; \
        sr_[i].vs0 = St::ld8(vb_ + sr * 1024 + sc); sr_[i].vs1 = St::ld8(vb_ + (32 + sr) * 1024 + sc); \
        sr_[i].ks0 = St::ld8(kb_ + sr * 1024 + sc); sr_[i].ks1 = St::ld8(kb_ + (32 + sr) * 1024 + sc); } } while (0)
#define SWRITE(bi, i, t) do { \
        *(ATT_LAS bf16x8*)(V_lds + (bi) * 16384 + vst0) = St::tobf(sr_[i].vs0); *(ATT_LAS bf16x8*)(V_lds + (bi) * 16384 + vst1) = St::tobf(sr_[i].vs1); \
        *(ATT_LAS bf16x8*)(K_lds + (bi) * 16384 + KSWZ(sr, sc * 2)) = St::tobf(sr_[i].ks0); *(ATT_LAS bf16x8*)(K_lds + (bi) * 16384 + KSWZ(32 + sr, sc * 2)) = St::tobf(sr_[i].ks1); \
        if constexpr (KIND == 3) { if ((t) >= 1 && (t) <= 7) { const size_t o_ = (size_t)((t) - 1) * 65536 + sr * 1024 + sc; \
            *(typename St::T*)(okb + o_) = sr_[i].ks0; *(typename St::T*)(okb + o_ + 32 * 1024) = sr_[i].ks1; *(typename St::T*)(ovb + o_) = sr_[i].vs0; *(typename St::T*)(ovb + o_ + 32 * 1024) = sr_[i].vs1; } } } while (0)
#define SWAIT() do { if constexpr (SDEPTH == 2) asm volatile("s_waitcnt vmcnt(4)" ::: "memory"); } while (0)
#define RESC(a) do { if (__any((a) < 1.f)) { if (hi == 0) al_l[r32] = (a); asm volatile("s_waitcnt lgkmcnt(0)" ::: "memory"); \
        _Pragma("unroll") for (int d_ = 0; d_ < 4; ++d_) _Pragma("unroll") for (int r_ = 0; r_ < 16; ++r_) o[d_][r_] *= al_l[crow(r_, hi)]; } } while (0)
#define SCORE(P0_, P1_, bi, t) do { if (active) { bool val_ = true; int dc_ = 0; \
        if constexpr (KIND == 0) { if ((t) == NT - 1 && lastmask) val_ = false; } \
        if constexpr (KIND >= 2) { dc_ = cw - (kc0 + (t)); val_ = (dc_ >= 0 && dc_ <= 8); } \
        if (val_) { qkt<NQ>(P0_, P1_, K_lds + (bi) * 16384, qr, d0b, r32, hi); \
            if constexpr (KIND >= 2) { \
                if (dc_ >= 3) { _Pragma("unroll") for (int r_ = 0; r_ < 16; ++r_) { P0_[r_] += c256; P1_[r_] += c256; } } \
                else { const int base_ = 64 * dc_ + qi + 128; \
                    _Pragma("unroll") for (int r_ = 0; r_ < 16; ++r_) { int i0_ = base_ - crow(r_, hi); int i1_ = i0_ - 32; i0_ = i0_ > 256 ? 256 : i0_; i1_ = i1_ > 256 ? 256 : i1_; P0_[r_] += tab[i0_]; P1_[r_] += tab[i1_]; if ((r_ & 3) == 3) asm volatile("" ::: "memory"); } } } } \
        else { _Pragma("unroll") for (int r_ = 0; r_ < 16; ++r_) { P0_[r_] = -INFINITY; P1_[r_] = -INFINITY; } } } } while (0)
    f32x16 pA0, pA1; float alA = 1.f; bf16x8 pa0, pa1, pa2, pa3;
    if constexpr (IS_S) {
        const int ntl = tsplit + 1;
        if (wid >= 4) {
            int ltid = tid - 256; asm volatile("" : "+v"(ltid));
            const int lr = ltid >> 5, lc = (ltid & 31) * 4;
            struct LR { f32x4 k[8], v[8]; }; LR R0, R1;
#define LLOAD(R, t) do { const float* kb_ = ((t) < tsplit) ? (const float*)Kt0 + (size_t)(t) * 65536 : (const float*)Kt1; const float* vb_ = ((t) < tsplit) ? (const float*)Vt0 + (size_t)(t) * 65536 : (const float*)Vt1; \
            _Pragma("unroll") for (int i_ = 0; i_ < 8; ++i_) { R.k[i_] = *reinterpret_cast<const f32x4*>(kb_ + (lr + 8 * i_) * 1024 + lc); R.v[i_] = *reinterpret_cast<const f32x4*>(vb_ + (lr + 8 * i_) * 1024 + lc); } } while (0)
#define LWRITE(R, bi, t) do { _Pragma("unroll") for (int i_ = 0; i_ < 8; ++i_) { const int row_ = lr + 8 * i_; \
                u32x2l wk_, wv_; wk_.x = cvtpk(R.k[i_][0], R.k[i_][1]); wk_.y = cvtpk(R.k[i_][2], R.k[i_][3]); wv_.x = cvtpk(R.v[i_][0], R.v[i_][1]); wv_.y = cvtpk(R.v[i_][2], R.v[i_][3]); \
                *(ATT_LAS u32x2l*)(K_lds + (bi) * 16384 + KSWZ(row_, lc * 2)) = wk_; *(ATT_LAS u32x2l*)(V_lds + (bi) * 16384 + v_st(row_, lc)) = wv_; \
                if constexpr (KIND == 3) { float* ok_ = (t) >= 1 ? okb + (size_t)((t) - 1) * 65536 : P.dummy; float* ov_ = (t) >= 1 ? ovb + (size_t)((t) - 1) * 65536 : P.dummy; \
                    __builtin_nontemporal_store(R.k[i_], (f32x4*)(ok_ + row_ * 1024 + lc)); __builtin_nontemporal_store(R.v[i_], (f32x4*)(ov_ + row_ * 1024 + lc)); } } \
            asm volatile("s_waitcnt lgkmcnt(0)" ::: "memory"); } while (0)
            const int lastt = ntl - 1;
            if constexpr (KIND == 1 && ATT_L3) {
                LR R2;
                LLOAD(R0, 0); LLOAD(R1, 1); LLOAD(R2, 2);
                int t = 0;
                for (; t + 2 < ntl; t += 3) {
                    LWRITE(R0, (t & 1), t); { const int tn = t + 3 < lastt ? t + 3 : lastt; LLOAD(R0, tn); } __builtin_amdgcn_s_barrier();
                    LWRITE(R1, ((t + 1) & 1), t + 1); { const int tn = t + 4 < lastt ? t + 4 : lastt; LLOAD(R1, tn); } __builtin_amdgcn_s_barrier();
                    LWRITE(R2, (t & 1), t + 2); { const int tn = t + 5 < lastt ? t + 5 : lastt; LLOAD(R2, tn); } __builtin_amdgcn_s_barrier();
                }
                if (t < ntl) { LWRITE(R0, (t & 1), t); __builtin_amdgcn_s_barrier(); ++t; }
                if (t < ntl) { LWRITE(R1, (t & 1), t); __builtin_amdgcn_s_barrier(); }
            } else {
                int t = 0;
                bool conv = false;
                if constexpr (KIND == 1) conv = P.conv_on != 0;
                if (conv) {
                    const int lwg = u * 4 + (wid - 4), kr = lane >> 3, nq = lane & 7, c = lane >> 3, n8 = lane & 7;
                    LAS float* scr = (LAS float*)(lds + 69632) + (wid - 4) * 2112;
                    f32x4 cv[8], ga_, gb_;
#if CONV_L2
                    LLOAD(R0, 0); LLOAD(R1, 1);
                    { const TrDesc d0 = tr_desc_ffn2(lwg, P.in, P.wsb); TR_LOAD(cv, d0); }
#define CONV_STEP(tt) do { const TrDesc d = tr_desc_ffn2((tt) * 1024 + lwg, P.in, P.wsb), dn = tr_desc_ffn2(((tt) + 1 < 24 ? (tt) + 1 : 23) * 1024 + lwg, P.in, P.wsb); TR_TO_LDS(cv); TR_G(d); TR_LOAD(cv, dn); TR_OUT(d); } while (0)
#pragma nounroll
                    for (; t < 24; t += 2) {
                        { const int lr0_ = lr, lc0_ = lc; { int lr = lr0_, lc = lc0_; asm volatile("" : "+v"(lr), "+v"(lc)); LWRITE(R0, 0, t); LLOAD(R0, t + 2); } } CONV_STEP(t); __builtin_amdgcn_s_barrier();
                        { const int lr0_ = lr, lc0_ = lc; { int lr = lr0_, lc = lc0_; asm volatile("" : "+v"(lr), "+v"(lc)); LWRITE(R1, 1, t + 1); LLOAD(R1, t + 3); } } CONV_STEP(t + 1); __builtin_amdgcn_s_barrier();
                    }
#undef CONV_STEP
#else
                    LLOAD(R0, 0);
                    { const TrDesc d0 = tr_desc_ffn2(lwg, P.in, P.wsb); TR_LOAD(cv, d0); }
                    for (; t < 24; ++t) {
                        LWRITE(R0, (t & 1), t); LLOAD(R0, t + 1);
                        { const TrDesc d = tr_desc_ffn2(t * 1024 + lwg, P.in, P.wsb), dn = tr_desc_ffn2((t + 1 < 24 ? t + 1 : 23) * 1024 + lwg, P.in, P.wsb); TR_TO_LDS(cv); TR_G(d); TR_LOAD(cv, dn); TR_OUT(d); }
                        __builtin_amdgcn_s_barrier();
                    }
                    LLOAD(R1, 25);
#endif
                } else { LLOAD(R0, 0); LLOAD(R1, 1); }
                for (; t + 1 < ntl; t += 2) {
                    LWRITE(R0, 0, t); { const int tn = t + 2 < lastt ? t + 2 : lastt; LLOAD(R0, tn); } __builtin_amdgcn_s_barrier();
                    LWRITE(R1, 1, t + 1); { const int tn = t + 3 < lastt ? t + 3 : lastt; LLOAD(R1, tn); } __builtin_amdgcn_s_barrier();
                }
                if (t < ntl) { LWRITE(R0, 0, t); __builtin_amdgcn_s_barrier(); }
            }
#undef LLOAD
#undef LWRITE
        } else {
            o[0] = f32x16{}; o[1] = f32x16{}; o[2] = f32x16{}; o[3] = f32x16{};
#pragma unroll
            for (int d = 0; d < NQ; ++d) qr[d] = *reinterpret_cast<const bf16x8*>(Qw + (size_t)r32 * 1024 + d * 16 + hi * 8);
            for (int t = 0; t < ntl; ++t) {
                __builtin_amdgcn_s_barrier();
                if (active) {
                    SCORE(pA0, pA1, (t & 1), t); partialSM(pA0, pA1, m_reg, alA); RESC(alA);
                    finishSM(pA0, pA1, alA, l_reg, pa0, pa1, pa2, pa3); SBAR();
                    pv_d0(o, vb0 + (t & 1) * 16384, pa0, pa1, pa2, pa3);
                }
            }
        }
    } else if constexpr (KIND != 0 || ATT_SIMPLE0) {
        const int ntl = NT;
        SLOAD(0, 0); SWRITE(0, 0, 0); __syncthreads();
        for (int t = 0; t < ntl; ++t) {
            if (t + 1 < ntl) SLOAD(0, t + 1);
            bool tile_on = active;
            if constexpr (KIND == 2) { const int dcw = cw - (kc0 + t); tile_on = (dcw >= 0 && dcw <= 8); }
            if (tile_on) {
                SCORE(pA0, pA1, (t & 1), t); partialSM(pA0, pA1, m_reg, alA); RESC(alA);
                finishSM(pA0, pA1, alA, l_reg, pa0, pa1, pa2, pa3); SBAR();
                pv_d0(o, vb0 + (t & 1) * 16384, pa0, pa1, pa2, pa3);
            }
            if (t + 1 < ntl) SWRITE(((t + 1) & 1), 0, t + 1);
            __syncthreads();
        }
    } else {
        f32x16 pB0, pB1; float alB = 1.f;
        constexpr int SE = 0, SO = SDEPTH - 1;
        SLOAD(SE, 0); SWRITE(0, SE, 0); __syncthreads();
        SCORE(pA0, pA1, 0, 0); if (active) partialSM(pA0, pA1, m_reg, alA);
        SLOAD(SO, 1); if constexpr (SDEPTH == 2) { if (2 < NT) SLOAD(SE, 2); }
        SWAIT(); SWRITE(1, SO, 1); __syncthreads();
#if ATT_ROT
        const bool rot = (map != 0);
        for (int j = 1; j + 1 < NT; j += 2) {
            SBAR();
            if (!rot) { SCORE(pB0, pB1, 1, j); SBAR(); finishSM(pA0, pA1, alA, l_reg, pa0, pa1, pa2, pa3); }
            else { finishSM(pA0, pA1, alA, l_reg, pa0, pa1, pa2, pa3); SBAR(); SCORE(pB0, pB1, 1, j); }
            SBAR(); SLOAD(SO, j + SDEPTH); SBAR();
            if (!rot) { pv_d0(o, vb0, pa0, pa1, pa2, pa3); SBAR(); partialSM(pB0, pB1, m_reg, alB); }
            else { partialSM(pB0, pB1, m_reg, alB); SBAR(); pv_d0(o, vb0, pa0, pa1, pa2, pa3); }
            __syncthreads(); SWAIT(); SWRITE(0, SE, j + 1);
            RESC(alB); __syncthreads();
            SBAR();
            if (!rot) { SCORE(pA0, pA1, 0, j + 1); SBAR(); finishSM(pB0, pB1, alB, l_reg, pa0, pa1, pa2, pa3); }
            else { finishSM(pB0, pB1, alB, l_reg, pa0, pa1, pa2, pa3); SBAR(); SCORE(pA0, pA1, 0, j + 1); }
            SBAR(); if (SDEPTH == 1 || j + 3 < NT) SLOAD(SE, j + 1 + SDEPTH); SBAR();
            if (!rot) { pv_d0(o, vb0 + 16384, pa0, pa1, pa2, pa3); SBAR(); partialSM(pA0, pA1, m_reg, alA); }
            else { partialSM(pA0, pA1, m_reg, alA); SBAR(); pv_d0(o, vb0 + 16384, pa0, pa1, pa2, pa3); }
            __syncthreads(); SWAIT(); SWRITE(1, SO, j + 2);
            RESC(alA); __syncthreads();
        }
#else
        for (int j = 1; j + 1 < NT; j += 2) {
            SBAR(); SCORE(pB0, pB1, 1, j);
            if (active) finishSM(pA0, pA1, alA, l_reg, pa0, pa1, pa2, pa3); SBAR();
            SLOAD(SO, j + SDEPTH); SBAR();
            if (active) { pv_d0(o, vb0, pa0, pa1, pa2, pa3); partialSM(pB0, pB1, m_reg, alB); }
            __syncthreads(); SWAIT(); SWRITE(0, SE, j + 1);
            if (active) RESC(alB); __syncthreads();
            SBAR(); SCORE(pA0, pA1, 0, j + 1);
            if (active) finishSM(pB0, pB1, alB, l_reg, pa0, pa1, pa2, pa3); SBAR();
            if (SDEPTH == 1 || j + 3 < NT) SLOAD(SE, j + 1 + SDEPTH); SBAR();
            if (active) { pv_d0(o, vb0 + 16384, pa0, pa1, pa2, pa3); partialSM(pA0, pA1, m_reg, alA); }
            __syncthreads(); SWAIT(); SWRITE(1, SO, j + 2);
            if (active) RESC(alA); __syncthreads();
        }
#endif
        if constexpr (!IS_S) { SBAR(); SCORE(pB0, pB1, 1, NT - 1); }
        if (active) finishSM(pA0, pA1, alA, l_reg, pa0, pa1, pa2, pa3); SBAR();
        if (active) pv_d0(o, vb0, pa0, pa1, pa2, pa3);
        if constexpr (!IS_S) {
            partialSM(pB0, pB1, m_reg, alB); RESC(alB);
            finishSM(pB0, pB1, alB, l_reg, pa0, pa1, pa2, pa3); SBAR();
            pv_d0(o, vb0 + 16384, pa0, pa1, pa2, pa3);
        }
    }
    if (active) {
        if (hi == 0) li_l[r32] = l_reg; asm volatile("s_waitcnt lgkmcnt(0)" ::: "memory");
#pragma unroll
        for (int r = 0; r < 16; ++r) { const float rl = __builtin_amdgcn_rcpf(li_l[crow(r, hi)]);
#pragma unroll
            for (int d0 = 0; d0 < 4; ++d0) o[d0][r] *= rl; }
    }
    if constexpr (IS_A) {
        __syncthreads();
        ATT_LAS float* xb = (ATT_LAS float*)lds + pslot * 4096 + lane;
        if (active && map == 1) {
#pragma unroll
            for (int d0 = 0; d0 < 4; ++d0)
#pragma unroll
                for (int r = 0; r < 16; ++r) xb[(d0 * 16 + r) * 64] = o[d0][r];
        }
        __syncthreads();
        if (active && map == 0) {
            const float lam = P.lam;
#pragma unroll
            for (int d0 = 0; d0 < 4; ++d0)
#pragma unroll
                for (int r = 0; r < 16; ++r) o[d0][r] -= lam * xb[(d0 * 16 + r) * 64];
            float g[4];
#pragma unroll
            for (int d0 = 0; d0 < 4; ++d0) g[d0] = P.subln[32 * d0 + r32] * (1.0f - LAM_INIT);
#pragma unroll
            for (int r = 0; r < 16; ++r) {
                float ss = o[0][r] * o[0][r] + o[1][r] * o[1][r] + o[2][r] * o[2][r] + o[3][r] * o[3][r];
                ss += __shfl_xor(ss, 1); ss += __shfl_xor(ss, 2); ss += __shfl_xor(ss, 4); ss += __shfl_xor(ss, 8); ss += __shfl_xor(ss, 16);
                const float rn = 1.0f / sqrtf(ss * (1.0f / 128.0f) + EPS);
                bf16* op = P.OAB + (size_t)(qrow + crow(r, hi)) * DM + h * 128 + r32;
#pragma unroll
                for (int d0 = 0; d0 < 4; ++d0) op[32 * d0] = (bf16)f2bf(o[d0][r] * rn * g[d0]);
            }
        }
    } else {
        if (active) {
#pragma unroll
            for (int r = 0; r < 16; ++r) { bf16* op = P.OAB + (size_t)(qrow + crow(r, hi)) * DM + 1024 + h * 128 + r32;
#pragma unroll
                for (int d0 = 0; d0 < 4; ++d0) op[32 * d0] = (bf16)f2bf(o[d0][r]); }
        }
    }
    __syncthreads();
#undef SLOAD
#undef SWRITE
#undef SWAIT
#undef RESC
#undef SCORE
}
#undef SBAR
}

#define NORM_LOAD(v, m_) do { \
        if constexpr (BF16IN) { const v4u* xr_ = (const v4u*)((m_) < MP ? (const bf16*)xlo + (size_t)(m_) * DM : (const bf16*)xhi + (size_t)((m_) - MP) * DM) + lane; \
            _Pragma("unroll") for (int jj_ = 0; jj_ < 4; ++jj_) { const v4u w_ = xr_[64 * jj_]; v[2 * jj_] = (f32x4){bf_lo(w_.x), bf_hi(w_.x), bf_lo(w_.y), bf_hi(w_.y)}; v[2 * jj_ + 1] = (f32x4){bf_lo(w_.z), bf_hi(w_.z), bf_lo(w_.w), bf_hi(w_.w)}; } } \
        else { const f32x4* xr_ = (const f32x4*)((m_) < MP ? (const float*)xlo + (size_t)(m_) * DM : (const float*)xhi + (size_t)((m_) - MP) * DM) + lane; \
            _Pragma("unroll") for (int j_ = 0; j_ < 8; ++j_) v[j_] = xr_[64 * j_]; } } while (0)
#define NORM_OUT(v, m_) do { float s_ = 0.f; \
        _Pragma("unroll") for (int j_ = 0; j_ < 8; ++j_) s_ += (v[j_].x * v[j_].x + v[j_].y * v[j_].y) + (v[j_].z * v[j_].z + v[j_].w * v[j_].w); \
        const float rstd_ = 1.0f / sqrtf(wave_sum(s_) * (1.0f / DM) + EPS); \
        if constexpr (F32OUT && BF16IN) { float* o_ = (float*)out + (size_t)(m_) * DM + 8 * lane; \
            _Pragma("unroll") for (int j_ = 0; j_ < 8; ++j_) __builtin_nontemporal_store(v[j_] * rstd_ * gv[j_], (f32x4*)(o_ + 512 * (j_ >> 1) + 4 * (j_ & 1))); } \
        else if constexpr (F32OUT) { f32x4* o_ = (f32x4*)((float*)out + (size_t)(m_) * DM) + lane; \
            _Pragma("unroll") for (int j_ = 0; j_ < 8; ++j_) __builtin_nontemporal_store(v[j_] * rstd_ * gv[j_], &o_[64 * j_]); } \
        else if constexpr (BF16IN) { v4u* o16_ = (v4u*)((bf16*)out + (size_t)(m_) * DM) + lane; \
            _Pragma("unroll") for (int jj_ = 0; jj_ < 4; ++jj_) { const f32x4 y0_ = v[2 * jj_] * rstd_ * gv[2 * jj_], y1_ = v[2 * jj_ + 1] * rstd_ * gv[2 * jj_ + 1]; \
                v4u w_; w_.x = pk2(y0_.x, y0_.y); w_.y = pk2(y0_.z, y0_.w); w_.z = pk2(y1_.x, y1_.y); w_.w = pk2(y1_.z, y1_.w); o16_[64 * jj_] = w_; } } \
        else { unsigned long long* o8_ = (unsigned long long*)((bf16*)out + (size_t)(m_) * DM) + lane; \
            _Pragma("unroll") for (int j_ = 0; j_ < 8; ++j_) { const f32x4 y_ = v[j_] * rstd_ * gv[j_]; o8_[64 * j_] = (unsigned long long)pk2(y_.x, y_.y) | ((unsigned long long)pk2(y_.z, y_.w) << 32); } } } while (0)
template <bool F32OUT, bool BF16IN> __device__ __forceinline__ void norm_rows(const void* __restrict__ xlo, const void* __restrict__ xhi, const float* __restrict__ g, void* __restrict__ out, int gw, int NGW, int lane) {
    f32x4 gv[8];
#pragma unroll
    for (int j = 0; j < 8; ++j) gv[j] = BF16IN ? *(const f32x4*)(g + 8 * lane + 512 * (j >> 1) + 4 * (j & 1)) : ((const f32x4*)g)[lane + 64 * j];
    if (gw >= M) return;
    f32x4 vA[8], vB[8];
    int mA = gw, mB = gw + NGW < M ? gw + NGW : gw;
    NORM_LOAD(vA, mA); NORM_LOAD(vB, mB);
    int m = gw;
    for (; m + NGW < M; m += 2 * NGW) {
        { const int cur = mA; NORM_OUT(vA, cur); mA = (cur + 2 * NGW < M) ? cur + 2 * NGW : cur; NORM_LOAD(vA, mA); }
        { const int cur = mB; NORM_OUT(vB, cur); mB = (cur + 2 * NGW < M) ? cur + 2 * NGW : cur; NORM_LOAD(vB, mB); }
    }
    if (m < M) { NORM_OUT(vA, mA); }
}
#undef NORM_LOAD
#undef NORM_OUT
__constant__ float ROPE_INV[32] = {
    1.000000000e+00f, 7.498942614e-01f, 5.623413324e-01f, 4.216965139e-01f, 3.162277639e-01f, 2.371373773e-01f, 1.778279394e-01f, 1.333521307e-01f,
    1.000000015e-01f, 7.498941571e-02f, 5.623413250e-02f, 4.216965288e-02f, 3.162277490e-02f, 2.371373773e-02f, 1.778279431e-02f, 1.333521493e-02f,
    9.999999776e-03f, 7.498941850e-03f, 5.623413250e-03f, 4.216964822e-03f, 3.162277630e-03f, 2.371373586e-03f, 1.778279431e-03f, 1.333521446e-03f,
    1.000000047e-03f, 7.498942432e-04f, 5.623413017e-04f, 4.216965172e-04f, 3.162277571e-04f, 2.371373703e-04f, 1.778279402e-04f, 1.333521504e-04f };

struct Args { const float* in[26]; float* out; unsigned char* ws; int ph_lo, ph_hi, li, pad; };
__global__ void __launch_bounds__(NWAVES * 64, 2) fwd_kernel(Args args) {
    extern __shared__ __attribute__((aligned(16))) unsigned char lds_raw[];
    LAS unsigned char* lds = (LAS unsigned char*)lds_raw;
    volatile LAS unsigned* MISC = (volatile LAS unsigned*)(lds + MISC_OFF);
    const int tid = threadIdx.x, lane = tid & 63, wave = __builtin_amdgcn_readfirstlane(tid >> 6);
    const int G = gridDim.x; int vcu; { const int bx = blockIdx.x; vcu = (G % 8 == 0) ? (bx % 8) * (G / 8) + bx / 8 : bx; }
    const int gw = vcu * NWAVES + wave, NGW = G * NWAVES;
    unsigned char* ws = args.ws;
    gu32* ctl = (gu32*)(ws + WS_CTL);
    for (int i = tid; i < (LDS_BYTES - LDSCTL_OFF) / 4; i += NWAVES * 64) ((LAS unsigned*)(lds + LDSCTL_OFF))[i] = 0u;
    __syncthreads();
    XcdBarrier bar; bar.bar = (unsigned*)(ctl + CW_BAR); bar.x = 0; bar.st = nullptr;
    if (N_LAUNCHES == 1) bar = xcd_barrier_post((unsigned*)(ctl + CW_BAR), MISC + 8);
#ifdef BAR_TWICE
#define GRID_BAR() do { if (N_LAUNCHES == 1) { xcd_barrier(bar); xcd_barrier(bar); } } while (0)
#else
#define GRID_BAR() do { if (N_LAUNCHES == 1) xcd_barrier(bar); } while (0)
#endif
    const int lo = args.ph_lo, hi = args.ph_hi;
#ifndef PHMASK
#define PHMASK 0xFFF
#endif
#define IN(k) ((((PHMASK) >> (k)) & 1) && lo <= (k) && (k) < hi)
#define BOTH(k) (IN(k) && IN((k) + 1))
#ifndef REPMASK
#define REPMASK 0
#endif
#if REPMASK == 0
#define REP(k)
#else
#define REP(k) _Pragma("unroll") for (int rep_ = 0; rep_ < 1 + (((REPMASK) >> (k)) & 1); ++rep_)
#endif
    constexpr int R5 = 1 + (((REPMASK) >> 5) & 1);
    const float* x_prompt = args.in[0]; const float* x_sample = args.in[1];
    bf16* W1 = (bf16*)(ws + WS_W1); bf16* W1D = (bf16*)(ws + WS_W1D); bf16* WIN = (bf16*)(ws + WS_WIN); bf16* WBR = (bf16*)(ws + WS_WBR); bf16* WOUT = (bf16*)(ws + WS_WOUT);
    bf16* W2 = (bf16*)(ws + WS_W2); bf16* W2D = (bf16*)(ws + WS_W2D);
    bf16* H = (bf16*)(ws + WS_H); bf16* ACT = (bf16*)(ws + WS_ACT); unsigned char* X1 = ws + WS_X1; unsigned char* X2 = ws + WS_X2; unsigned char* X3 = ws + WS_X1;
#define XHI(p) ((p) + (size_t)MP * DM * (RESID_BF16 ? 2 : 4))
    bf16* QA = (bf16*)(ws + WS_QA); bf16* KA = (bf16*)(ws + WS_KA); bf16* VA = (bf16*)(ws + WS_VA); bf16* QB = (bf16*)(ws + WS_QB); bf16* KB = (bf16*)(ws + WS_KB); bf16* VB = (bf16*)(ws + WS_VB);
    bf16* SGA = (bf16*)(ws + WS_SGA); bf16* SGB = (bf16*)(ws + WS_SGB); bf16* OAB = (bf16*)(ws + WS_OAB); bf16* MRG = (bf16*)(ws + WS_MRG);
    float* RCOS = (float*)(ws + WS_ROPE); float* RSIN = RCOS + 4096 * 32;
    float* RS_MIX = (float*)(ctl + CW_RS); float* RS_FFN2 = RS_MIX + M;
#ifndef RESID_BF16
#define RESID_BF16 1
#endif
static_assert(!NORM_FOLD || RESID_BF16, "NORM_FOLD feeds the bf16 residual stream to the next GEMM as its A operand");
#ifndef FINAL_FUSE
#define FINAL_FUSE 1
#endif
static_assert(!FINAL_FUSE || (N_LAUNCHES == 1 && RESID_BF16), "FINAL_FUSE: grid barrier inside the last GEMM epilogue, bf16 residual stream");
#ifndef X3_BF16
#define X3_BF16 0
#endif
#ifndef CONV_IN_ATTN
#define CONV_IN_ATTN 1
#endif
#ifndef GEMM_ALIGN
#define GEMM_ALIGN true
#endif
#ifndef GEMM_SP2
#define GEMM_SP2 true
#endif
#ifndef FUSE_NORM
#define FUSE_NORM 0
#endif
#define RUN_GEMM(EpiT, E_, A_, B_, N_, K_) do { pg8::Gemm g_{(const pg8::bf16_t*)(A_), (const pg8::bf16_t*)(B_), M, (N_), (K_)}; pg8::StaticOrder S_; S_.init(M, (N_), (K_), G, (int)blockIdx.x); \
        pg8::gemm_phase<EpiT, pg8::StaticOrder, GEMM_ALIGN, GEMM_SP2, false>(lds, g_, S_, E_); } while (0)
#define RUN_GEMM_SK(EpiT, E_, A_, B_, N_, K_, bank_) do { pg8::Gemm g_{(const pg8::bf16_t*)(A_), (const pg8::bf16_t*)(B_), M, (N_), (K_)}; pg8::SplitOrder S_; \
        S_.init(M, (N_), (K_), G, (int)blockIdx.x, (float*)(ws + WS_SLAB + (size_t)(bank_) * SLAB_BANK), (unsigned*)(ctl + CW_SK + (bank_) * SK_BANK), (unsigned*)(ctl + CW_TMO)); \
        pg8::gemm_phase<EpiT, pg8::SplitOrder, GEMM_ALIGN, GEMM_SP2, true>(lds, g_, S_, E_); } while (0)

    if (IN(0)) REP(0) {
        LAS float* scr = (LAS float*)(lds + wave * 16384);
        constexpr int I_FF = 32 * 256, I_D = 128 * 64, I_IN = 32 * 320, I_BR = 16 * 64, I_O = 32 * 64;
        constexpr int NITEMS = 2 * (2 * I_FF + I_D) + I_IN + 2 * I_BR + I_O;
        if (NGW == 2048) p0_convert_stream(args.in, ws, scr, gw, lane, CONV_IN_ATTN ? 12 : 0);
        else for (int it = gw; it < NITEMS; it += NGW) {
            int r = it;
            if (r < I_FF) { tr_item<1>(args.in[22], FF, W2, DM, 0, scr, r, lane, NORM_FOLD ? args.in[21] : nullptr); continue; } r -= I_FF;
            if (r < I_FF) { tr_item<2>(args.in[23], FF, W2, DM, 0, scr, r, lane, NORM_FOLD ? args.in[21] : nullptr); continue; } r -= I_FF;
            if (r < I_D) { tr_item<0>(args.in[24], DM, W2D, FF, 0, scr, r, lane); continue; } r -= I_D;
            if (r < I_O) { tr_item<0>(args.in[20], DM, WOUT, DM, 0, scr, r, lane); continue; } r -= I_O;
            if (r < I_BR) { tr_item<0>(args.in[18], DM, WBR, DM, 0, scr, r, lane); continue; } r -= I_BR;
            if (r < I_BR) { tr_item<0>(args.in[19], DM, WBR, DM, 1024, scr, r, lane); continue; } r -= I_BR;
            if (r < I_IN) { tr_item<3>(args.in[11], NIN, WIN, DM, 0, scr, r, lane, NORM_FOLD ? args.in[10] : nullptr); continue; } r -= I_IN;
            if (r < I_D) { tr_item<0>(args.in[9], DM, W1D, FF, 0, scr, r, lane); continue; } r -= I_D;
            if (r < I_FF) { tr_item<1>(args.in[7], FF, W1, DM, 0, scr, r, lane); continue; } r -= I_FF;
            tr_item<2>(args.in[8], FF, W1, DM, 0, scr, r, lane);
        }
        for (int e = vcu * (NWAVES * 64) + tid; e < 4096 * 32; e += G * NWAVES * 64) {
            const int pos = e >> 5, i = e & 31;
            const float ang = (float)pos * ROPE_INV[i];
            double rev = (double)ang * 0.15915494309189535; rev -= __builtin_rint(rev);
            const float fr = (float)rev;
            RCOS[e] = __builtin_amdgcn_cosf(fr); RSIN[e] = __builtin_amdgcn_sinf(fr);
        }
        norm_rows<false, false>(x_prompt, x_sample, args.in[6], H, gw, NGW, lane);
        if (BOTH(0)) GRID_BAR();
    }
    if (IN(1)) REP(1) { EpiSwiglu<false> E{ACT, nullptr}; RUN_GEMM(EpiSwiglu<false>, E, H, W1, 2 * FF, DM); if (BOTH(1)) GRID_BAR(); }
#if FUSE_NORM
    if (IN(2)) REP(2) { EpiResidNorm E{x_prompt, x_sample, X1, 0.5f, args.in[10], H, RS_MIX}; RUN_GEMM_SK(EpiResidNorm, E, ACT, W1D, DM, FF, 0); if (BOTH(2)) GRID_BAR(); }
#else
    if (IN(2)) REP(2) { typedef EpiResid<false, RESID_BF16 != 0, NORM_FOLD != 0> EP; EP E{x_prompt, x_sample, X1, 0.5f, RS_MIX}; RUN_GEMM_SK(EP, E, ACT, W1D, DM, FF, 0); if (BOTH(2)) GRID_BAR(); }
#endif
#if !FUSE_NORM
    if (!NORM_FOLD && IN(3)) REP(3) { norm_rows<false, RESID_BF16 != 0>(X1, XHI(X1), args.in[10], H, gw, NGW, lane); if (BOTH(3)) GRID_BAR(); }
#endif
    if (IN(4)) REP(4) { EpiWin<(FUSE_NORM || NORM_FOLD)> E{QA, KA, VA, QB, KB, VB, SGA, SGB, args.out, RCOS, RSIN, RS_MIX}; RUN_GEMM_SK(EpiWin<(FUSE_NORM || NORM_FOLD)>, E, (NORM_FOLD ? (const bf16*)X1 : H), WIN, NIN, DM, 1); if (BOTH(4)) GRID_BAR(); }
    if (IN(5)) {
        float lam;
        { const float s1 = wave_sum(args.in[12][lane] * args.in[13][lane]), s2 = wave_sum(args.in[14][lane] * args.in[15][lane]); lam = expf(s1) - expf(s2) + LAM_INIT; }
        const att::AttnP AP{QA, KA, VA, QB, KB, VB, OAB, args.in[2], args.in[3], args.in[4], args.in[5], args.out, args.in[17], args.in[16], (float*)(ws + WS_SLAB), lam, args.in, ws, (CONV_IN_ATTN && NGW == 2048) ? 1 : 0};
        ATT_LAS char* al = (ATT_LAS char*)lds;
#ifndef KMASK
#define KMASK 15
#endif
#ifndef REPK
#define REPK 0
#endif
#define RK(k) (1 + (((REPK) >> (k)) & 1))
#define SAMPLE_UNITS() do { if (KMASK & 2) for (int u = vcu; u < 256 * RK(1); u += G) att::attn_unit<1>(AP, u & 255, al); \
                            if (KMASK & 8) for (int u = vcu; u < 256 * RK(3); u += G) att::attn_unit<3>(AP, u & 255, al); } while (0)
        const bool sample_first = (vcu & 1) == 0;
        if (sample_first) SAMPLE_UNITS();
        if (KMASK & 1) for (int i = vcu; i < 512 * RK(0); i += G) { const int v = i & 255, s = v & 15, qt = ((i >> 8) & 1) ? 31 - s : s; att::attn_unit<0>(AP, (v >> 4) * 32 + qt, al); }
        if (KMASK & 4) for (int u = vcu; u < 256 * RK(2); u += G) att::attn_unit<2>(AP, u & 255, al);
        if (!sample_first) SAMPLE_UNITS();
#undef SAMPLE_UNITS
        if (BOTH(5)) GRID_BAR();
    }
    if (IN(6)) REP(6) { EpiMerge E{SGA, SGB, MRG}; RUN_GEMM_SK(EpiMerge, E, OAB, WBR, DM, DM, 2); if (BOTH(6)) GRID_BAR(); }
#if FUSE_NORM
    if (IN(7)) REP(7) { EpiResidNorm E{X1, X1 + (size_t)MP * DM, X2, 1.0f, args.in[21], H, RS_FFN2}; RUN_GEMM_SK(EpiResidNorm, E, MRG, WOUT, DM, DM, 3); if (BOTH(7)) GRID_BAR(); }
#else
    if (IN(7)) REP(7) { typedef EpiResid<RESID_BF16 != 0, RESID_BF16 != 0, NORM_FOLD != 0> EP; EP E{X1, XHI(X1), X2, 1.0f, RS_FFN2}; RUN_GEMM_SK(EP, E, MRG, WOUT, DM, DM, 3); if (BOTH(7)) GRID_BAR(); }
    if (!NORM_FOLD && IN(8)) REP(8) { norm_rows<false, RESID_BF16 != 0>(X2, XHI(X2), args.in[21], H, gw, NGW, lane); if (BOTH(8)) GRID_BAR(); }
#endif
    if (IN(9)) REP(9) { EpiSwiglu<(FUSE_NORM || NORM_FOLD)> E{ACT, RS_FFN2}; RUN_GEMM(EpiSwiglu<(FUSE_NORM || NORM_FOLD)>, E, (NORM_FOLD ? (const bf16*)X2 : H), W2, 2 * FF, DM); if (BOTH(9)) GRID_BAR(); }
#if FINAL_FUSE
    if (IN(10)) { EpiFinal E{(const bf16*)X2, (const bf16*)XHI(X2), (float*)X3, args.out, args.in[25], RS_FFN2 + M, 0.5f, bar}; RUN_GEMM_SK(EpiFinal, E, ACT, W2D, DM, FF, 4); }
#else
    if (IN(10)) REP(10) { typedef EpiResid<RESID_BF16 != 0, X3_BF16 != 0, false> EP; EP E{X2, XHI(X2), X3, 0.5f, nullptr}; RUN_GEMM_SK(EP, E, ACT, W2D, DM, FF, 4); if (BOTH(10)) GRID_BAR(); }
    if (IN(11)) REP(11) { norm_rows<true, X3_BF16 != 0>(X3, X3 + (size_t)MP * DM * (X3_BF16 ? 2 : 4), args.in[25], args.out, gw, NGW, lane); }
#endif
#undef IN
#undef BOTH
}

extern "C" void kernel_launch(void* const* d_in, const int* in_sizes, int n_in, void* d_out, int out_size, void* d_ws, size_t ws_size, hipStream_t stream) {
    static int grid = 0;
    if (grid == 0) {
        if (n_in != 26 || in_sizes[0] != MP * DM || in_sizes[1] != MS * DM || (size_t)out_size != OUT_ELEMS || ws_size < WS_END) {
            fprintf(stderr, "kernel_launch: shape mismatch: n_in %d in0 %d in1 %d out %d ws %zu (need >= %zu); nothing launched\n", n_in, n_in > 0 ? in_sizes[0] : -1, n_in > 1 ? in_sizes[1] : -1, out_size, ws_size, (size_t)WS_END); grid = -1; return; }
        int dev = 0, cus = 0, per_cu = 0;
        if (hipGetDevice(&dev) != hipSuccess || hipDeviceGetAttribute(&cus, hipDeviceAttributeMultiprocessorCount, dev) != hipSuccess) { fprintf(stderr, "kernel_launch: device query failed\n"); grid = -1; return; }
        if (hipFuncSetAttribute((const void*)fwd_kernel, hipFuncAttributeMaxDynamicSharedMemorySize, LDS_BYTES) != hipSuccess) { fprintf(stderr, "kernel_launch: hipFuncSetAttribute failed\n"); grid = -1; return; }
        if (hipOccupancyMaxActiveBlocksPerMultiprocessor(&per_cu, (const void*)fwd_kernel, NWAVES * 64, LDS_BYTES) != hipSuccess || per_cu < 1) { fprintf(stderr, "kernel_launch: occupancy query reports %d workgroups per CU; nothing launched\n", per_cu); (void)hipGetLastError(); grid = -1; return; }
        (void)hipGetLastError();
        grid = cus;
    }
    if (grid < 0) return;
    if (hipMemsetAsync((char*)d_ws + WS_CTL, 0, CTL_ZERO_BYTES, stream) != hipSuccess) { fprintf(stderr, "kernel_launch: memset failed\n"); return; }
    Args a{};
    for (int i = 0; i < 26; ++i) a.in[i] = (const float*)d_in[i];
    a.out = (float*)d_out; a.ws = (unsigned char*)d_ws;
    for (int li = 0; li < N_LAUNCHES; ++li) {
        a.ph_lo = (N_LAUNCHES == 1) ? 0 : li; a.ph_hi = (N_LAUNCHES == 1) ? N_PHASES : li + 1; a.li = li; a.pad = 0;
        hipLaunchKernelGGL(fwd_kernel, dim3(grid), dim3(NWAVES * 64), LDS_BYTES, stream, a);
        const hipError_t le = hipPeekAtLastError();
        if (le != hipSuccess) { fprintf(stderr, "kernel_launch: launch %d failed: %s\n", li, hipGetErrorName(le)); break; }
    }
}
```

```cpp
#include <hip/hip_runtime.h>
#include <cstdio>
#include <cstdint>
#include <type_traits>
namespace pg8 {
#define PG8_LAS __attribute__((address_space(3)))
typedef unsigned short bf16_t;
typedef short bf16x8 __attribute__((ext_vector_type(8)));
typedef float f32x4 __attribute__((ext_vector_type(4)));
typedef unsigned u32x4 __attribute__((ext_vector_type(4)));
constexpr int BM = 256, BK = 64, HALF = 128, HTB = HALF * BK * 2  , STAGE_BYTES = 8 * HTB, NXCD = 8, WGM = 8;

__host__ __device__ __forceinline__ int lds_byte(int r, int c) { const int st = (r >> 4) * 2 + (c >> 5), rr = r & 15, cc = c & 31, ob = rr * 64 + cc * 2; return st * 1024 + (ob ^ (((ob >> 9) & 1) << 5)); }
__host__ __device__ __forceinline__ void stage_rc(int b, int& R, int& C) { const int st = b / 1024, sb = b % 1024, swz = sb ^ (((sb >> 9) & 1) << 5); R = (st >> 1) * 16 + swz / 64; C = (st & 1) * 32 + (swz % 64) / 2; }
__host__ __device__ __forceinline__ int perm32(int rho) { const int n = rho >> 4, i = rho & 15; return 8 * (i >> 2) + 4 * n + (i & 3); }

struct Unit { int pm, pn, k0, nk, role, slab; };
struct Gemm { const bf16_t* A; const bf16_t* Bt; int M, N, K; };

struct StaticOrder {
    int nM, nN, nwg, G, c, KT;
    __host__ __device__ __forceinline__ void init(int M, int N, int K, int G_, int c_) { nM = M / BM; nN = N / BM; nwg = nM * nN; G = G_; c = c_; KT = K / BK; }
    __host__ __device__ __forceinline__ bool next(int i, Unit& u) const {
        const long L = (long)i * G + c; if (L >= nwg) return false;
        int wgid = (int)L; { const int q = nwg / NXCD, r = nwg % NXCD, xcd = wgid % NXCD, off = wgid / NXCD; wgid = (xcd < r ? xcd * (q + 1) : r * (q + 1) + (xcd - r) * q) + off; }
        const int nig = WGM * nN, gid = wgid / nig, fm = gid * WGM, gsz = (nM - fm) < WGM ? (nM - fm) : WGM;
        u.pm = fm + ((wgid % nig) % gsz); u.pn = (wgid % nig) / gsz; u.k0 = 0; u.nk = KT; u.role = 0; u.slab = 0; return true;
    }
    __device__ __forceinline__ void a_ready(const Unit&) const {}
    __device__ __forceinline__ void done(const Unit&) const {}
};

struct SplitOrder {
    int nM, nN, KT, G, c, F, NF, j, r, q4, ntiles; bool enabled;
    float* slabs; unsigned* cnt; unsigned* tmo;
    __device__ __forceinline__ void init(int M, int N, int K, int G_, int c_, float* slabs_, unsigned* cnt_, unsigned* tmo_) {
        nM = M / BM; nN = N / BM; KT = K / BK; G = G_; c = c_; slabs = slabs_; cnt = cnt_; tmo = tmo_;
        ntiles = nM * nN; F = ntiles / G; NF = F * G; q4 = KT / 4;
        enabled = (G % 32 == 0) && ((ntiles - NF) * 4 == G) && (KT % 8 == 0) && F >= 1;
        const int xcd = c % NXCD, idx = c / NXCD; j = xcd * (G / 32) + idx / 4; r = idx % 4;
    }
    __device__ __forceinline__ void tile(int q, Unit& u) const { const int nig = WGM * nN, gid = q / nig, fm = gid * WGM, gsz = (nM - fm) < WGM ? (nM - fm) : WGM, w = q % nig; u.pm = fm + w % gsz; u.pn = w / gsz; }
    __device__ __forceinline__ void full_tile(int L, Unit& u) const { const int wgid = (L % NXCD) * (NF / NXCD) + L / NXCD; tile(wgid, u); u.k0 = 0; u.nk = KT; u.role = 0; u.slab = 0; }
    __device__ __forceinline__ bool next(int i, Unit& u) const {
        if (!enabled) { const int L = i * G + c; if (L >= ntiles) return false; tile(L, u); u.k0 = 0; u.nk = KT; u.role = 0; u.slab = 0; return true; }
        if (r < 3) {
            if (i == 0) { tile(NF + j, u); u.k0 = r * q4; u.nk = q4; u.role = 1; u.slab = j * 3 + r; return true; }
            if (i <= F) { full_tile((i - 1) * G + c, u); return true; }
            return false;
        }
        if (i < F) { full_tile(i * G + c, u); return true; }
        if (i == F) { tile(NF + j, u); u.k0 = 3 * q4; u.nk = q4; u.role = 2; u.slab = j * 3; return true; }
        return false;
    }
};
__device__ __forceinline__ unsigned cvt_pk_bf16(float lo, float hi) { unsigned r; asm volatile("v_cvt_pk_bf16_f32 %0, %1, %2" : "=v"(r) : "v"(lo), "v"(hi)); return r; }
__device__ __forceinline__ void sk_store(const f32x4 (&acc)[2][2][4][2], float* slab, unsigned* cnt, int wid, int lane) {
    u32x4* p = (u32x4*)slab + (wid * 16 * 64 + lane);
#pragma unroll
    for (int e = 0; e < 16; ++e) { const f32x4 v0 = acc[e >> 3][(e >> 2) & 1][e & 3][0], v1 = acc[e >> 3][(e >> 2) & 1][e & 3][1];
        u32x4 w; w.x = cvt_pk_bf16(v0[0], v0[1]); w.y = cvt_pk_bf16(v0[2], v0[3]); w.z = cvt_pk_bf16(v1[0], v1[1]); w.w = cvt_pk_bf16(v1[2], v1[3]);
        u32x4* q = p + e * 64;
        asm volatile("global_store_dwordx4 %0, %1, off sc1\n\ts_nop 1" :: "v"(q), "v"(w) : "memory"); }
    asm volatile("s_waitcnt vmcnt(0)" ::: "memory");
    if (lane == 0) __hip_atomic_fetch_add(cnt, 1u, __ATOMIC_RELAXED, __HIP_MEMORY_SCOPE_AGENT);
}
__device__ __forceinline__ void sk_wait(unsigned* cnt, unsigned need, unsigned* tmo, int lane) {
    unsigned spins = 0;
    while ((unsigned)__builtin_amdgcn_readfirstlane(__hip_atomic_load(cnt, __ATOMIC_RELAXED, __HIP_MEMORY_SCOPE_AGENT)) < need) {
        __builtin_amdgcn_s_sleep(2);
        if (++spins > (1u << 20)) { if (lane == 0) __hip_atomic_store(tmo, 1u, __ATOMIC_RELAXED, __HIP_MEMORY_SCOPE_AGENT); break; }
    }
    __builtin_amdgcn_fence(__ATOMIC_ACQUIRE, "agent");
}
__device__ __forceinline__ void sk_load(f32x4 (&acc)[2][2][4][2], const float* slab, int wid, int lane) {
    typedef __attribute__((address_space(1))) const u32x4 gu4;
    int t_ = threadIdx.x; asm volatile("" : "+v"(t_));
    const int lofs = (t_ >> 6) * 16 * 64 + (t_ & 63);
    gu4* p = (gu4*)((const u32x4*)slab + lofs);
#pragma unroll
    for (int g = 0; g < 2; ++g) {
        u32x4 t[24];
#pragma unroll
        for (int e = 0; e < 8; ++e) { const int i = 8 * g + e; t[3 * e] = p[i * 64]; t[3 * e + 1] = p[i * 64 + 8192]; t[3 * e + 2] = p[i * 64 + 16384]; }
        asm volatile("" :: "v"(t[0]), "v"(t[1]), "v"(t[2]), "v"(t[3]), "v"(t[4]), "v"(t[5]), "v"(t[6]), "v"(t[7]), "v"(t[8]), "v"(t[9]), "v"(t[10]), "v"(t[11]),
                          "v"(t[12]), "v"(t[13]), "v"(t[14]), "v"(t[15]), "v"(t[16]), "v"(t[17]), "v"(t[18]), "v"(t[19]), "v"(t[20]), "v"(t[21]), "v"(t[22]), "v"(t[23]) : "memory");
#pragma unroll
        for (int e = 0; e < 8; ++e) { const int i = 8 * g + e; const u32x4 a = t[3 * e], b = t[3 * e + 1], c = t[3 * e + 2];
#define BFLO(w) __builtin_bit_cast(float, (w) << 16)
#define BFHI(w) __builtin_bit_cast(float, (w) & 0xffff0000u)
            acc[i >> 3][(i >> 2) & 1][i & 3][0] = (f32x4){(BFLO(a.x) + BFLO(b.x)) + BFLO(c.x), (BFHI(a.x) + BFHI(b.x)) + BFHI(c.x), (BFLO(a.y) + BFLO(b.y)) + BFLO(c.y), (BFHI(a.y) + BFHI(b.y)) + BFHI(c.y)};
            acc[i >> 3][(i >> 2) & 1][i & 3][1] = (f32x4){(BFLO(a.z) + BFLO(b.z)) + BFLO(c.z), (BFHI(a.z) + BFHI(b.z)) + BFHI(c.z), (BFLO(a.w) + BFLO(b.w)) + BFLO(c.w), (BFHI(a.w) + BFHI(b.w)) + BFHI(c.w)};
#undef BFLO
#undef BFHI
        }
    }
}

typedef float f32x2 __attribute__((ext_vector_type(2)));
#ifndef EPI_BUMP
#define EPI_BUMP 0
#endif
#ifndef GEMM_NT_B
#define GEMM_NT_B 0
#endif
template <class Epi, class Sched, bool ALIGN_EPI = false, bool SP2 = false, bool SPLITK = false>
__device__ __forceinline__ void gemm_phase(PG8_LAS unsigned char* lds, const Gemm g, const Sched& S, const Epi& E) {
    const int tid = threadIdx.x, wid = __builtin_amdgcn_readfirstlane(tid >> 6), lane = tid & 63, wr = wid >> 2, wc = wid & 3, fr = lane & 15, fq = lane >> 4;
    static_assert(SP2, "the K-loop trip below is the two-super-phase schedule (the four-phase variant was slower and is gone)");
    const int K = g.K;
    unsigned voffA[2], voffB[2];
#pragma unroll
    for (int i = 0; i < 2; ++i) { int R, C; stage_rc(tid * 16 + i * 8192, R, C); const int Rb = Epi::PERM ? ((R & ~31) + perm32(R & 31)) : R;
        voffA[i] = (unsigned)(R * K + C) * 2u; voffB[i] = (unsigned)(Rb * K + C) * 2u; }
    const size_t kstep = (size_t)(BK * 2);
    const size_t hstep = (size_t)HALF * K * 2;
    const size_t tstep = 2 * hstep;
    const unsigned ldsw = (unsigned)wid * 1024u;
    const int aoff = lds_byte(wr * 64 + fr, fq * 8), boff = lds_byte(wc * 32 + fr, fq * 8);
#define PG8_SA(b, h) (((b) * 2 + (h)) * HTB)
#define PG8_SB(b, h) ((4 + (b) * 2 + (h)) * HTB)
#define PG8_STAGE(bufoff, gbase, voff) do { _Pragma("unroll") for (int _i = 0; _i < 2; ++_i) \
        __builtin_amdgcn_global_load_lds((const unsigned*)((const char*)(gbase) + (voff)[_i]), (PG8_LAS unsigned*)(lds + (bufoff) + ldsw + _i * 8192), 16, 0, 0); } while (0)
#define PG8_STAGEB(bufoff, gbase, voff) do { _Pragma("unroll") for (int _i = 0; _i < 2; ++_i) \
        __builtin_amdgcn_global_load_lds((const unsigned*)((const char*)(gbase) + (voff)[_i]), (PG8_LAS unsigned*)(lds + (bufoff) + ldsw + _i * 8192), 16, 0, GEMM_NT_B); } while (0)
#define PG8_LDA(dst, b, h) do { _Pragma("unroll") for (int m = 0; m < 4; ++m) _Pragma("unroll") for (int k = 0; k < 2; ++k) dst[m][k] = *(const PG8_LAS bf16x8*)(lds + PG8_SA(b, h) + aoff + m * 2048 + k * 1024); } while (0)
#define PG8_LDB(dst, b, h) do { _Pragma("unroll") for (int n = 0; n < 2; ++n) _Pragma("unroll") for (int k = 0; k < 2; ++k) dst[n][k] = *(const PG8_LAS bf16x8*)(lds + PG8_SB(b, h) + boff + n * 2048 + k * 1024); } while (0)
#define PG8_MMA(ai, bj, At, Bt) do { __builtin_amdgcn_s_setprio(1); _Pragma("unroll") for (int m = 0; m < 4; ++m) _Pragma("unroll") for (int n = 0; n < 2; ++n) _Pragma("unroll") for (int k = 0; k < 2; ++k) \
        acc[ai][bj][m][n] = __builtin_amdgcn_mfma_f32_16x16x32_bf16(Bt[n][k], At[m][k], acc[ai][bj][m][n], 0, 0, 0); __builtin_amdgcn_s_setprio(0); } while (0)
#define PG8_WAIT_V(n) asm volatile("s_waitcnt vmcnt(" #n ")" ::: "memory")
#define PG8_WAIT_L(n) asm volatile("s_waitcnt lgkmcnt(" #n ")" ::: "memory")
#define PG8_BAR __builtin_amdgcn_s_barrier()
#define PG8_SCHED __builtin_amdgcn_sched_barrier(0)
    Unit cur, nxt; int ui = 0;
    if (!S.next(0, cur)) { if constexpr (Epi::DEFER) E.bar_only(); return; }
    f32x4 acc[2][2][4][2];
#pragma unroll
    for (int a = 0; a < 2; ++a)
#pragma unroll
        for (int b = 0; b < 2; ++b)
#pragma unroll
            for (int m = 0; m < 4; ++m)
#pragma unroll
                for (int n = 0; n < 2; ++n) acc[a][b][m][n] = (f32x4){0.f, 0.f, 0.f, 0.f};
    float pre[8] = {0.f, 0.f, 0.f, 0.f, 0.f, 0.f, 0.f, 0.f};
    bf16x8 At[4][2], B0[2][2], B1[2][2];
    const char* cA = (const char*)g.A + (size_t)cur.pm * tstep + (size_t)cur.k0 * kstep; const char* cB = (const char*)g.Bt + (size_t)cur.pn * tstep + (size_t)cur.k0 * kstep;
    if constexpr (SP2) {
        PG8_STAGEB(PG8_SB(0, 0), cB, voffB); PG8_STAGEB(PG8_SB(0, 1), cB + hstep, voffB); PG8_STAGE(PG8_SA(0, 0), cA, voffA); PG8_STAGE(PG8_SA(0, 1), cA + hstep, voffA);
        if (wr == 1) PG8_BAR;
        PG8_WAIT_V(2); PG8_BAR;
        PG8_STAGEB(PG8_SB(1, 0), cB + kstep, voffB); PG8_STAGE(PG8_SA(1, 0), cA + kstep, voffA); PG8_STAGEB(PG8_SB(1, 1), cB + hstep + kstep, voffB);
        PG8_WAIT_V(6); PG8_BAR;
    } else {
        PG8_STAGEB(PG8_SB(0, 0), cB, voffB); PG8_STAGE(PG8_SA(0, 0), cA, voffA); PG8_STAGEB(PG8_SB(0, 1), cB + hstep, voffB); PG8_STAGE(PG8_SA(0, 1), cA + hstep, voffA);
        if (wr == 1) PG8_BAR;
        PG8_WAIT_V(4); PG8_BAR;
        PG8_STAGEB(PG8_SB(1, 0), cB + kstep, voffB); PG8_STAGE(PG8_SA(1, 0), cA + kstep, voffA); PG8_STAGEB(PG8_SB(1, 1), cB + hstep + kstep, voffB);
        PG8_WAIT_V(6); PG8_BAR;
    }
    constexpr bool BUMP = (((EPI_BUMP) >> Epi::EPI_ID) & 1) && Epi::NVM > 0;
    bool ep_prev = false;
    for (;;) {
        const bool has_next = S.next(ui + 1, nxt);
        const char* nA = has_next ? (const char*)g.A + (size_t)nxt.pm * tstep + (size_t)nxt.k0 * kstep : cA; const char* nB = has_next ? (const char*)g.Bt + (size_t)nxt.pn * tstep + (size_t)nxt.k0 * kstep : cB;
        const int nt = cur.nk;
#define PG8_WAIT_VM(mode) asm volatile("s_waitcnt vmcnt(%1)\n\ts_cmp_eq_u32 %0, 1\n\ts_cbranch_scc1 1f\n\ts_waitcnt vmcnt(16)\n\ts_cmp_eq_u32 %0, 2\n\ts_cbranch_scc1 1f\n\ts_waitcnt vmcnt(8)\n1:" \
            :: "s"(mode), "n"(8 + (Epi::NVM > 8 ? Epi::NVM : 8)) : "memory", "scc")
#define PG8_WAIT_VP(n, np) do { if constexpr (Epi::HAS_PRE || BUMP) PG8_WAIT_VM(wm); else PG8_WAIT_V(n); } while (0)
#define PG8_WAIT_VQ(n, np) do { if constexpr (Epi::HAS_PRE) PG8_WAIT_VM(wm3); else PG8_WAIT_V(n); } while (0)
        for (int t = 0; t < nt; t += 2) {
            if constexpr (Epi::HAS_MID) { if (t > 0 && cur.k0 + t == Epi::KMID) E.mid(acc, cur, wr, wc, fr, fq); }
            const bool last = (t == nt - 2), first = ep_prev && t == 0;
            const int wm = __builtin_amdgcn_readfirstlane((Epi::HAS_PRE && last) ? 2 : ((BUMP && first) ? 1 : 0)), wm3 = __builtin_amdgcn_readfirstlane((Epi::HAS_PRE && last) ? 2 : 0);
            const char* a1 = cA + (size_t)(t + 1) * kstep;
            const char* a2 = last ? nA : cA + (size_t)(t + 2) * kstep; const char* b2 = last ? nB : cB + (size_t)(t + 2) * kstep;
            const char* a3 = a2 + kstep; const char* b3 = b2 + kstep;
            PG8_LDB(B0, 0, 0); PG8_LDB(B1, 0, 1); PG8_SCHED; PG8_LDA(At, 0, 0); PG8_STAGE(PG8_SA(1, 1), a1 + hstep, voffA);
            if constexpr (Epi::HAS_PRE) { if (last) E.pre(pre, cur, wr, fr); }
            PG8_WAIT_VP(8, 16); PG8_WAIT_L(0); PG8_BAR; PG8_MMA(0, 0, At, B0); PG8_MMA(0, 1, At, B1); PG8_BAR; PG8_SCHED;
            PG8_LDA(At, 0, 1); PG8_STAGEB(PG8_SB(0, 0), b2, voffB); PG8_STAGEB(PG8_SB(0, 1), b2 + hstep, voffB); PG8_STAGE(PG8_SA(0, 0), a2, voffA);
            PG8_WAIT_VP(8, 16); PG8_WAIT_L(0); PG8_BAR; PG8_MMA(1, 0, At, B0); PG8_MMA(1, 1, At, B1); PG8_BAR; PG8_SCHED;
            PG8_LDB(B0, 1, 0); PG8_LDB(B1, 1, 1); PG8_SCHED; PG8_LDA(At, 1, 0); PG8_STAGE(PG8_SA(0, 1), a2 + hstep, voffA);
            PG8_WAIT_VQ(8, 16); PG8_WAIT_L(0); PG8_BAR; PG8_MMA(0, 0, At, B0); PG8_MMA(0, 1, At, B1); PG8_BAR; PG8_SCHED;
            PG8_LDA(At, 1, 1); PG8_STAGEB(PG8_SB(1, 0), b3, voffB); PG8_STAGEB(PG8_SB(1, 1), b3 + hstep, voffB); PG8_STAGE(PG8_SA(1, 0), a3, voffA);
            PG8_WAIT_V(8);
            PG8_WAIT_L(0); PG8_BAR; PG8_MMA(1, 0, At, B0); PG8_MMA(1, 1, At, B1); PG8_BAR; PG8_SCHED;
        }
#undef PG8_WAIT_VP
#undef PG8_WAIT_VQ
#undef PG8_WAIT_VM
        if constexpr (ALIGN_EPI) { if (wr == 0) PG8_BAR; }
        if constexpr (Epi::DEFER) {
            bool part = false; if constexpr (SPLITK) part = (cur.role == 1);
            if (part) { sk_store(acc, S.slabs + (size_t)cur.slab * 32768, S.cnt + (cur.slab / 3) * 16, wid, lane); if (!has_next) E.bar_only(); }
            else E.fin(acc, cur, wr, wc, fr, fq, !has_next);
        } else
        if constexpr (SPLITK) {
            if (cur.role == 1) { if constexpr (Epi::HAS_MID) { if (cur.k0 + cur.nk <= Epi::KMID) E.mid(acc, cur, wr, wc, fr, fq); }
                sk_store(acc, S.slabs + (size_t)cur.slab * 32768, S.cnt + (cur.slab / 3) * 16, wid, lane); }
            else { E(acc, cur, wr, wc, fr, fq, pre); }
        } else { E(acc, cur, wr, wc, fr, fq, pre); }
        if (!has_next) break;
        ep_prev = true; if constexpr (SPLITK) ep_prev = (cur.role != 1);
        bool inherit = false;
        if constexpr (SPLITK) inherit = (nxt.role == 2);
        if constexpr (SPLITK) { if (inherit) { sk_wait(S.cnt + (nxt.slab / 3) * 16, 24u, S.tmo, lane); sk_load(acc, S.slabs + (size_t)nxt.slab * 32768, wid, lane); } }
        if (!inherit) {
#pragma unroll
            for (int a = 0; a < 2; ++a)
#pragma unroll
                for (int b = 0; b < 2; ++b)
#pragma unroll
                    for (int m = 0; m < 4; ++m)
#pragma unroll
                        for (int n = 0; n < 2; ++n) acc[a][b][m][n] = (f32x4){0.f, 0.f, 0.f, 0.f};
        }
        cur = nxt; cA = nA; cB = nB; ++ui;
        if constexpr (ALIGN_EPI) { if (wr == 1) PG8_BAR; }
    }
    if constexpr (Epi::DEFER) for (int j = 0; j < ui; ++j) { Unit u; if (S.next(j, u)) { bool pj = false; if constexpr (SPLITK) pj = (u.role == 1); if (!pj) E.fix(acc, u, wr, wc, fr, fq); } }
    PG8_WAIT_V(0);
    if constexpr (!ALIGN_EPI) { if (wr == 0) PG8_BAR; }
    PG8_BAR;
#undef PG8_SA
#undef PG8_SB
#undef PG8_STAGE
#undef PG8_STAGEB
#undef PG8_LDA
#undef PG8_LDB
#undef PG8_MMA
#undef PG8_WAIT_V
#undef PG8_WAIT_L
#undef PG8_BAR
#undef PG8_SCHED
}
}
#define GAS __attribute__((address_space(1)))
#define LAS __attribute__((address_space(3)))
typedef unsigned short bf16;
typedef unsigned v4u __attribute__((ext_vector_type(4)));
typedef float f32x4 __attribute__((ext_vector_type(4)));
typedef short bf16x8 __attribute__((ext_vector_type(8)));
typedef GAS unsigned gu32;
typedef GAS unsigned long long gu64;
#define RLX_AGENT __ATOMIC_RELAXED, __HIP_MEMORY_SCOPE_AGENT
#define LDS_WAIT() asm volatile("s_waitcnt lgkmcnt(0)" ::: "memory")
#define VM_WAIT() asm volatile("s_waitcnt vmcnt(0)" ::: "memory")
__device__ __forceinline__ unsigned long long rt() { return __builtin_amdgcn_s_memrealtime(); }
__device__ __forceinline__ unsigned f2bf(float f) { unsigned u = __builtin_bit_cast(unsigned, f); return (u + 0x7fffu + ((u >> 16) & 1u)) >> 16; }
__device__ __forceinline__ unsigned pk2(float lo, float hi) { return f2bf(lo) | (f2bf(hi) << 16); }

#define XB_TMO      128
#define XB_XCNT(j)  (256  + 64 * (j))
#define XB_XSUB(j)  (1280 + 64 * (j))
#define XB_XGEN(j)  (2304 + 64 * (j))
#define XB_TOP      3328
#define XB_TOPGEN   3392
#define XCD_BAR_WORDS 3456
#define XB_SPIN_CAP (1u << 18)

__device__ __forceinline__ unsigned xb_ld(unsigned* p)              { return __hip_atomic_load(p, __ATOMIC_RELAXED, __HIP_MEMORY_SCOPE_AGENT); }
__device__ __forceinline__ unsigned xb_add(unsigned* p, unsigned v) { return __hip_atomic_fetch_add(p, v, __ATOMIC_RELAXED, __HIP_MEMORY_SCOPE_AGENT); }
__device__ __forceinline__ unsigned xb_xcc_id() { return (unsigned)__builtin_amdgcn_s_getreg((3 << 11) | 20) & 0xFu; }
#define XB_SPIN(cond, bar) do { unsigned _sp = 0; while (cond) { __builtin_amdgcn_s_sleep(1); \
    if ((++_sp & 255u) == 0u) { if (xb_ld(&(bar)[XB_TMO])) break; if (_sp > XB_SPIN_CAP) { atomicAdd(&(bar)[XB_TMO], 1u); break; } } } } while (0)

struct XcdBarrier {
    unsigned* bar; unsigned x;
    volatile LAS unsigned* st;
};

__device__ __forceinline__ XcdBarrier xcd_barrier_post(unsigned* bar, volatile LAS unsigned* st) {
    XcdBarrier b; b.bar = bar; b.x = xb_xcc_id(); b.st = st;
    if (threadIdx.x == 0) (void)xb_add(&bar[XB_XCNT(b.x)], 1u);
    return b;
}
__device__ __forceinline__ void xcd_barrier_complete(unsigned* bar, unsigned x, unsigned& nloc, unsigned& nx) {
    const unsigned G = gridDim.x * gridDim.y * gridDim.z;
    unsigned sum, cnt, mine, sp = 0u;
    for (;;) {
        sum = 0u; cnt = 0u; mine = 0u;
#pragma unroll
        for (unsigned j = 0; j < 16; ++j) { const unsigned c = xb_ld(&bar[XB_XCNT(j)]); sum += c; cnt += (c > 0u) ? 1u : 0u; mine = (j == x) ? c : mine; }
        if (sum == G) break;
        __builtin_amdgcn_s_sleep(1);
        if ((++sp & 255u) == 0u) { if (xb_ld(&bar[XB_TMO])) break; if (sp > XB_SPIN_CAP) { atomicAdd(&bar[XB_TMO], 1u); break; } }
    }
    nloc = mine > 0u ? mine : 1u; nx = cnt > 0u ? cnt : 1u;
}

__device__ __forceinline__ void xcd_barrier(const XcdBarrier& b) {
    asm volatile("s_waitcnt vmcnt(0)" ::: "memory");
    __syncthreads();
    if (threadIdx.x == 0) {
        unsigned* bar = b.bar;
        __builtin_amdgcn_s_waitcnt(0);
        unsigned nloc = b.st[0], nx = b.st[1];
        if (nloc == 0u) { xcd_barrier_complete(bar, b.x, nloc, nx); b.st[0] = nloc; b.st[1] = nx; }
        const unsigned old = xb_add(&bar[XB_XSUB(b.x)], 1u);
        const unsigned gen = old / nloc;
        if (old + 1u == (gen + 1u) * nloc) {
            __builtin_amdgcn_fence(__ATOMIC_RELEASE, "agent");
            asm volatile("s_waitcnt vmcnt(0)" ::: "memory");
            const unsigned og = xb_add(&bar[XB_TOP], 1u);
            const unsigned tg = og / nx;
            if (og + 1u == (tg + 1u) * nx) xb_add(&bar[XB_TOPGEN], 1u);
            else XB_SPIN(xb_ld(&bar[XB_TOPGEN]) == tg, bar);
            __builtin_amdgcn_fence(__ATOMIC_ACQUIRE, "agent");
            xb_add(&bar[XB_XGEN(b.x)], 1u);
            asm volatile("s_waitcnt vmcnt(0)" ::: "memory");
        } else {
            XB_SPIN(xb_ld(&bar[XB_XGEN(b.x)]) == gen, bar);
            __builtin_amdgcn_fence(__ATOMIC_ACQUIRE, "agent");
            asm volatile("s_waitcnt vmcnt(0)" ::: "memory");
        }
    }
    __syncthreads();
}
__device__ __forceinline__ void xcd_barrier_later(const XcdBarrier& b) {
    asm volatile("s_waitcnt vmcnt(0)" ::: "memory");
    __syncthreads();
    if (threadIdx.x == 0) {
        unsigned* bar = b.bar;
        __builtin_amdgcn_s_waitcnt(0);
        unsigned nloc = b.st[0], nx = b.st[1];
        const unsigned old = xb_add(&bar[XB_XSUB(b.x)], 1u);
        const unsigned gen = old / nloc;
        if (old + 1u == (gen + 1u) * nloc) {
            __builtin_amdgcn_fence(__ATOMIC_RELEASE, "agent");
            asm volatile("s_waitcnt vmcnt(0)" ::: "memory");
            const unsigned og = xb_add(&bar[XB_TOP], 1u);
            const unsigned tg = og / nx;
            if (og + 1u == (tg + 1u) * nx) xb_add(&bar[XB_TOPGEN], 1u);
            else XB_SPIN(xb_ld(&bar[XB_TOPGEN]) == tg, bar);
            __builtin_amdgcn_fence(__ATOMIC_ACQUIRE, "agent");
            xb_add(&bar[XB_XGEN(b.x)], 1u);
            asm volatile("s_waitcnt vmcnt(0)" ::: "memory");
        } else {
            XB_SPIN(xb_ld(&bar[XB_XGEN(b.x)]) == gen, bar);
            __builtin_amdgcn_fence(__ATOMIC_ACQUIRE, "agent");
            asm volatile("s_waitcnt vmcnt(0)" ::: "memory");
        }
    }
    __syncthreads();
}

constexpr int NWAVES = 8;
#ifndef MK_N_LAUNCHES
#define MK_N_LAUNCHES 1
#endif
constexpr int N_PHASES = 12;
constexpr int N_LAUNCHES = MK_N_LAUNCHES;
static_assert(N_LAUNCHES == 1 || N_LAUNCHES == N_PHASES, "MK_N_LAUNCHES is 1 or 12");
constexpr int DM = 2048, FF = 8192, MP = 8192, MS = 2048, M = MP + MS, NIN = 10240;
#ifndef NORM_FOLD
#define NORM_FOLD 1
#endif
constexpr float EPS = 1e-6f, LOG2E = 1.4426950408889634f;
constexpr float QS_A = 0.125f * LOG2E;
constexpr float QS_B = 0.08838834764831845f * LOG2E;
constexpr float LAM_INIT = 0.2f;
constexpr size_t OFF_AKP = 20971520, OFF_AVP = 29360128, OFF_BKP = 37748736, OFF_BVP = 38797312, OFF_AKS = 39845888, OFF_AVS = 41943040, OFF_BKS = 44040192, OFF_BVS = 60817408, OUT_ELEMS = 77594624;
constexpr size_t MiB = 1u << 20;
constexpr size_t WS_CTL = 0, CTL_ZERO_BYTES = 1 * MiB;
constexpr size_t WS_ROPE = 1 * MiB;
constexpr size_t WS_W1 = 2 * MiB, WS_W1D = 66 * MiB, WS_WIN = 98 * MiB, WS_WBR = 138 * MiB, WS_WOUT = 146 * MiB, WS_W2 = 154 * MiB, WS_W2D = 218 * MiB;
constexpr size_t WS_H = 250 * MiB, WS_ACT = 290 * MiB, WS_X1 = 450 * MiB, WS_X2 = 530 * MiB;
constexpr size_t WS_QA = 610 * MiB, WS_KA = 630 * MiB, WS_VA = 650 * MiB, WS_QB = 670 * MiB, WS_KB = 690 * MiB, WS_VB = 710 * MiB, WS_SGA = 730 * MiB, WS_SGB = 770 * MiB, WS_OAB = 810 * MiB, WS_MRG = 850 * MiB, WS_SLAB = 890 * MiB  , SLAB_BANK = 48 * MiB, WS_END = 1130 * MiB;
constexpr int CW_RS = 65536;
constexpr int CW_TMO = 0, CW_BAR = 4096, CW_SK = 16384, SK_BANK = 256 * 16;
constexpr int RING_BYTES = 131072, LDSCTL_OFF = RING_BYTES, MISC_OFF = LDSCTL_OFF + 320, LDS_BYTES = 147456;

__device__ __forceinline__ float wave_sum(float v) {
#pragma unroll
    for (int o = 1; o < 64; o <<= 1) v += __shfl_xor(v, o);
    return v;
}
__device__ __forceinline__ float sigmoid_f(float x) { return __builtin_amdgcn_rcpf(1.f + __builtin_amdgcn_exp2f(-LOG2E * x)); }
__device__ __forceinline__ float bf_lo(unsigned w) { return __builtin_bit_cast(float, w << 16); }
__device__ __forceinline__ float bf_hi(unsigned w) { return __builtin_bit_cast(float, w & 0xffff0000u); }

#ifndef NT_ACT
#define NT_ACT 1
#endif
#define EPI_ARGS const pg8::f32x4 (&acc)[2][2][4][2], const pg8::Unit& un, int wr, int wc, int fr, int fq, const float (&pre)[8]
using pg8::cvt_pk_bf16;
typedef unsigned u32x2 __attribute__((ext_vector_type(2)));

#ifndef PRE_ASM
#define PRE_ASM 1
#endif
#if PRE_ASM
#define PRE_LOAD(dst, ptr, byteoff) asm volatile("global_load_dword %0, %1, off offset:%2 sc1" : "=v"(dst) : "v"(ptr), "n"(byteoff))
#else
#define PRE_LOAD(dst, ptr, byteoff) dst = __hip_atomic_load((const float*)((const char*)(ptr) + (byteoff)), __ATOMIC_RELAXED, __HIP_MEMORY_SCOPE_AGENT)
#endif
template <bool SCALE> struct EpiSwiglu {
    static constexpr int EPI_ID = 0;
    static constexpr bool DEFER = false;
    static constexpr int NVM = 8;
    static constexpr bool PERM = true, AFTER_DRAIN = false, HAS_MID = false, HAS_PRE = SCALE;
    __device__ __forceinline__ void pre(float (&p)[8], const pg8::Unit& un, int wr, int fr) const {
        int ro = wr * 64 + fr; asm volatile("" : "+v"(ro));
        const float* r = rowsum + un.pm * 256 + ro;
        PRE_LOAD(p[0], r, 0); PRE_LOAD(p[1], r, 64); PRE_LOAD(p[2], r, 128); PRE_LOAD(p[3], r, 192); PRE_LOAD(p[4], r, 512); PRE_LOAD(p[5], r, 576); PRE_LOAD(p[6], r, 640); PRE_LOAD(p[7], r, 704); }
    bf16* O; const float* rowsum;
    __device__ __forceinline__ void operator()(EPI_ARGS) const {
        const int row0 = un.pm * 256 + wr * 64 + fr, col0 = un.pn * 128 + wc * 32 + 8 * fq;
        float rs[2][4];
#pragma unroll
        for (int ai = 0; ai < 2; ++ai)
#pragma unroll
            for (int m = 0; m < 4; ++m) rs[ai][m] = SCALE ? __builtin_amdgcn_rsqf(pre[ai * 4 + m] * (1.0f / DM) + EPS) : 1.0f;
#pragma unroll
        for (int ai = 0; ai < 2; ++ai)
#pragma unroll
            for (int m = 0; m < 4; ++m) {
                bf16* p = O + (size_t)(row0 + ai * 128 + m * 16) * FF + col0;
                f32x4 g0 = acc[ai][0][m][0], g1 = acc[ai][0][m][1], u0 = acc[ai][1][m][0], u1 = acc[ai][1][m][1];
                if (SCALE) { g0 = g0 * rs[ai][m]; g1 = g1 * rs[ai][m]; u0 = u0 * rs[ai][m]; u1 = u1 * rs[ai][m]; }
                float a[8];
#pragma unroll
                for (int j = 0; j < 4; ++j) { a[j] = g0[j] * sigmoid_f(g0[j]) * u0[j]; a[4 + j] = g1[j] * sigmoid_f(g1[j]) * u1[j]; }
                v4u w; w.x = cvt_pk_bf16(a[0], a[1]); w.y = cvt_pk_bf16(a[2], a[3]); w.z = cvt_pk_bf16(a[4], a[5]); w.w = cvt_pk_bf16(a[6], a[7]);
#if NT_ACT
                __builtin_nontemporal_store(w, (v4u*)p);
#else
                *(v4u*)p = w;
#endif
            }
    }
};
template <bool INB, bool OUTB, bool SUMSQ, bool STORE = true> __device__ __forceinline__ void resid_tile(const void* __restrict__ ibv, void* __restrict__ obv, float* __restrict__ rsum, const pg8::f32x4 (&acc)[2][2][4][2], float scale, int fq) {
    typedef typename std::conditional<INB, bf16, float>::type TI; typedef typename std::conditional<OUTB, bf16, float>::type TO;
    const TI* __restrict__ ib = (const TI*)ibv; TO* __restrict__ ob = (TO*)obv;
    constexpr int NV = INB ? 2 : 4;
    v4u cur[NV], nxt[NV];
#pragma unroll
    for (int q = 0; q < NV; ++q) cur[q] = *(const v4u*)(ib + (INB ? q * 128 : (q >> 1) * 128 + (q & 1) * 4));
#pragma unroll
    for (int g = 0; g < 8; ++g) {
        const size_t off = (size_t)((g >> 2) * 128 + (g & 3) * 16) * DM;
        if (g + 1 < 8) { const size_t offn = (size_t)(((g + 1) >> 2) * 128 + ((g + 1) & 3) * 16) * DM;
#pragma unroll
            for (int q = 0; q < NV; ++q) nxt[q] = *(const v4u*)(ib + offn + (INB ? q * 128 : (q >> 1) * 128 + (q & 1) * 4)); }
        float ss = 0.f;
#pragma unroll
        for (int bj = 0; bj < 2; ++bj) {
            f32x4 r0, r1;
            if constexpr (INB) { const v4u w = cur[bj]; r0 = (f32x4){bf_lo(w.x), bf_hi(w.x), bf_lo(w.y), bf_hi(w.y)}; r1 = (f32x4){bf_lo(w.z), bf_hi(w.z), bf_lo(w.w), bf_hi(w.w)}; }
            else { r0 = __builtin_bit_cast(f32x4, cur[2 * bj]); r1 = __builtin_bit_cast(f32x4, cur[2 * bj + 1]); }
            const f32x4 x0 = r0 + acc[g >> 2][bj][g & 3][0] * scale, x1 = r1 + acc[g >> 2][bj][g & 3][1] * scale;
            if constexpr (SUMSQ) ss += ((x0[0] * x0[0] + x0[1] * x0[1]) + (x0[2] * x0[2] + x0[3] * x0[3])) + ((x1[0] * x1[0] + x1[1] * x1[1]) + (x1[2] * x1[2] + x1[3] * x1[3]));
            if constexpr (!STORE) { }
            else if constexpr (OUTB) { v4u w; w.x = cvt_pk_bf16(x0[0], x0[1]); w.y = cvt_pk_bf16(x0[2], x0[3]); w.z = cvt_pk_bf16(x1[0], x1[1]); w.w = cvt_pk_bf16(x1[2], x1[3]); *(v4u*)(ob + off + bj * 128) = w; }
            else { *(f32x4*)(ob + off + bj * 128) = x0; *(f32x4*)(ob + off + bj * 128 + 4) = x1; }
        }
        if constexpr (SUMSQ) { ss += __shfl_xor(ss, 16); ss += __shfl_xor(ss, 32);
            if (fq == 0) __hip_atomic_fetch_add(rsum + (g >> 2) * 128 + (g & 3) * 16, ss, __ATOMIC_RELAXED, __HIP_MEMORY_SCOPE_AGENT); }
#pragma unroll
        for (int q = 0; q < NV; ++q) cur[q] = nxt[q];
    }
}
template <bool INB, bool OUTB, bool SUMSQ = false> struct EpiResid {
    static constexpr int EPI_ID = 1;
    static constexpr bool DEFER = false;
    static constexpr int NVM = (INB ? 16 : 32) + (OUTB ? 16 : 32) > 48 ? 48 : (INB ? 16 : 32) + (OUTB ? 16 : 32);
    static constexpr bool PERM = true, AFTER_DRAIN = false, HAS_MID = false, HAS_PRE = false;
    const void* in_lo; const void* in_hi; void* out; float scale; float* rowsum;
    __device__ __forceinline__ void operator()(EPI_ARGS) const {
        const int row0 = un.pm * 256 + wr * 64 + fr, col0 = un.pn * 256 + wc * 32 + 8 * fq;
        const size_t off0 = (size_t)row0 * DM + col0;
        const char* ib = (un.pm < MP / 256) ? (const char*)in_lo + off0 * (INB ? 2 : 4) : (const char*)in_hi + (off0 - (size_t)MP * DM) * (INB ? 2 : 4);
        resid_tile<INB, OUTB, SUMSQ>(ib, (char*)out + off0 * (OUTB ? 2 : 4), rowsum + row0, acc, scale, fq);
    }
};
template <bool FROM_X3> __device__ __forceinline__ void final_tile(const void* __restrict__ ibv, float* __restrict__ ob, const float* __restrict__ rsum, const float* __restrict__ gn, const pg8::f32x4 (&acc)[2][2][4][2], float scale) {
    constexpr int NV = FROM_X3 ? 2 : 1;
    typedef typename std::conditional<FROM_X3, float, bf16>::type TI;
    const TI* __restrict__ ib = (const TI*)ibv;
#pragma unroll
    for (int bj = 0; bj < 2; ++bj) {
        const f32x4 g0 = *(const f32x4*)(gn + bj * 128), g1 = *(const f32x4*)(gn + bj * 128 + 4);
        float rcur = __hip_atomic_load(rsum, __ATOMIC_RELAXED, __HIP_MEMORY_SCOPE_AGENT), rnxt = 0.f;
        v4u cur[NV], nxt[NV];
#pragma unroll
        for (int q = 0; q < NV; ++q) cur[q] = *(const v4u*)(ib + bj * 128 + q * 4);
#pragma unroll
        for (int g = 0; g < 8; ++g) {
            if (g + 1 < 8) { const size_t offn = (size_t)(((g + 1) >> 2) * 128 + ((g + 1) & 3) * 16) * DM;
#pragma unroll
                for (int q = 0; q < NV; ++q) nxt[q] = *(const v4u*)(ib + offn + bj * 128 + q * 4);
                rnxt = __hip_atomic_load(rsum + ((g + 1) >> 2) * 128 + ((g + 1) & 3) * 16, __ATOMIC_RELAXED, __HIP_MEMORY_SCOPE_AGENT); }
            const float r = __builtin_amdgcn_rsqf(rcur * (1.0f / DM) + EPS);
            float* o = ob + (size_t)((g >> 2) * 128 + (g & 3) * 16) * DM + bj * 128;
            f32x4 x0, x1;
            if constexpr (FROM_X3) { x0 = __builtin_bit_cast(f32x4, cur[0]); x1 = __builtin_bit_cast(f32x4, cur[1]); }
            else { const v4u w = cur[0];
                x0 = (f32x4){bf_lo(w.x), bf_hi(w.x), bf_lo(w.y), bf_hi(w.y)} + acc[g >> 2][bj][g & 3][0] * scale; x1 = (f32x4){bf_lo(w.z), bf_hi(w.z), bf_lo(w.w), bf_hi(w.w)} + acc[g >> 2][bj][g & 3][1] * scale; }
            __builtin_nontemporal_store(x0 * r * g0, (f32x4*)o); __builtin_nontemporal_store(x1 * r * g1, (f32x4*)(o + 4));
#pragma unroll
            for (int q = 0; q < NV; ++q) cur[q] = nxt[q];
            rcur = rnxt;
        }
    }
}
struct EpiFinal {
    static constexpr int EPI_ID = 1;
    static constexpr bool DEFER = true;
    static constexpr int NVM = 0;
    static constexpr bool PERM = true, AFTER_DRAIN = false, HAS_MID = false, HAS_PRE = false;
    const bf16* in_lo; const bf16* in_hi; float* x3; float* out; const float* gain; float* rowsum; float scale; XcdBarrier bar;
    __device__ __forceinline__ void operator()(EPI_ARGS) const {}
    __device__ __forceinline__ void bar_only() const { xcd_barrier_later(bar); }
    __device__ __forceinline__ void fin(const pg8::f32x4 (&acc)[2][2][4][2], const pg8::Unit& un, int, int, int, int, bool lastu) const {
        int t_ = threadIdx.x; asm volatile("" : "+v"(t_));
        const int wr = t_ >> 8, wc = (t_ >> 6) & 3, fr = t_ & 15, fq = (t_ >> 4) & 3;
        const int row0 = un.pm * 256 + wr * 64 + fr, col0 = un.pn * 256 + wc * 32 + 8 * fq;
        const size_t off0 = (size_t)row0 * DM + col0;
        const bf16* ib = (un.pm < MP / 256) ? in_lo + off0 : in_hi + (off0 - (size_t)MP * DM);
        if (!lastu) resid_tile<true, false, true, true>(ib, x3 + off0, rowsum + row0, acc, scale, fq);
        else {
            resid_tile<true, false, true, false>(ib, x3 + off0, rowsum + row0, acc, scale, fq);
            xcd_barrier_later(bar);
            final_tile<false>(ib, out + off0, rowsum + row0, gain + col0, acc, scale);
        }
    }
    __device__ __forceinline__ void fix(const pg8::f32x4 (&acc)[2][2][4][2], const pg8::Unit& un, int, int, int, int) const {
        int t_ = threadIdx.x; asm volatile("" : "+v"(t_));
        const int wr = t_ >> 8, wc = (t_ >> 6) & 3, fr = t_ & 15, fq = (t_ >> 4) & 3;
        const int row0 = un.pm * 256 + wr * 64 + fr, col0 = un.pn * 256 + wc * 32 + 8 * fq;
        const size_t off0 = (size_t)row0 * DM + col0;
        final_tile<true>(x3 + off0, out + off0, rowsum + row0, gain + col0, acc, scale);
    }
};
__device__ __forceinline__ void resid_norm_tile(const float* __restrict__ ib, float* __restrict__ ob, bf16* __restrict__ hb, float* __restrict__ rsum, const float* __restrict__ gain,
                                                const pg8::f32x4 (&acc)[2][2][4][2], float scale, int fq) {
    f32x4 gv[4];
#pragma unroll
    for (int q = 0; q < 4; ++q) gv[q] = *(const f32x4*)(gain + (q >> 1) * 128 + (q & 1) * 4);
    f32x4 cur[4], nxt[4];
#pragma unroll
    for (int q = 0; q < 4; ++q) cur[q] = *(const f32x4*)(ib + (q >> 1) * 128 + (q & 1) * 4);
#pragma unroll
    for (int g = 0; g < 8; ++g) {
        const int rofs = (g >> 2) * 128 + (g & 3) * 16; const size_t off = (size_t)rofs * DM;
        if (g + 1 < 8) { const size_t offn = (size_t)(((g + 1) >> 2) * 128 + ((g + 1) & 3) * 16) * DM;
#pragma unroll
            for (int q = 0; q < 4; ++q) nxt[q] = *(const f32x4*)(ib + offn + (q >> 1) * 128 + (q & 1) * 4); }
        float ss = 0.f;
#pragma unroll
        for (int bj = 0; bj < 2; ++bj) {
            const f32x4 x0 = cur[2 * bj] + acc[g >> 2][bj][g & 3][0] * scale, x1 = cur[2 * bj + 1] + acc[g >> 2][bj][g & 3][1] * scale;
            *(f32x4*)(ob + off + bj * 128) = x0; *(f32x4*)(ob + off + bj * 128 + 4) = x1;
            ss += ((x0[0] * x0[0] + x0[1] * x0[1]) + (x0[2] * x0[2] + x0[3] * x0[3])) + ((x1[0] * x1[0] + x1[1] * x1[1]) + (x1[2] * x1[2] + x1[3] * x1[3]));
            const f32x4 y0 = x0 * gv[2 * bj], y1 = x1 * gv[2 * bj + 1];
            v4u w; w.x = cvt_pk_bf16(y0[0], y0[1]); w.y = cvt_pk_bf16(y0[2], y0[3]); w.z = cvt_pk_bf16(y1[0], y1[1]); w.w = cvt_pk_bf16(y1[2], y1[3]);
            *(v4u*)(hb + off + bj * 128) = w; }
        ss += __shfl_xor(ss, 16); ss += __shfl_xor(ss, 32);
        if (fq == 0) __hip_atomic_fetch_add(rsum + rofs, ss, __ATOMIC_RELAXED, __HIP_MEMORY_SCOPE_AGENT);
#pragma unroll
        for (int q = 0; q < 4; ++q) cur[q] = nxt[q];
    }
}
struct EpiResidNorm {
    static constexpr int EPI_ID = 1;
    static constexpr bool DEFER = false;
    static constexpr int NVM = 0;
    static constexpr bool PERM = true, AFTER_DRAIN = false, HAS_MID = false, HAS_PRE = false;
    const float* in_lo; const float* in_hi; float* out; float scale; const float* gain; bf16* hraw; float* rowsum;
    __device__ __forceinline__ void operator()(EPI_ARGS) const {
        const int row0 = un.pm * 256 + wr * 64 + fr, col0 = un.pn * 256 + wc * 32 + 8 * fq;
        const float* ib = (un.pm < MP / 256) ? in_lo : in_hi - (size_t)MP * DM;
        const size_t off0 = (size_t)row0 * DM + col0;
        resid_norm_tile(ib + off0, out + off0, hraw + off0, rowsum + row0, gain + col0, acc, scale, fq);
    }
};
template <bool SCALE> struct EpiWin {
    static constexpr int EPI_ID = 2;
    static constexpr bool DEFER = false;
    static constexpr int NVM = 16;
    static constexpr bool PERM = false, AFTER_DRAIN = false, HAS_MID = false, HAS_PRE = SCALE;
    __device__ __forceinline__ void pre(float (&p)[8], const pg8::Unit& un, int wr, int fr) const {
        int ro = wr * 64 + fr; asm volatile("" : "+v"(ro));
        const float* r = rowsum + un.pm * 256 + ro;
        PRE_LOAD(p[0], r, 0); PRE_LOAD(p[1], r, 64); PRE_LOAD(p[2], r, 128); PRE_LOAD(p[3], r, 192); PRE_LOAD(p[4], r, 512); PRE_LOAD(p[5], r, 576); PRE_LOAD(p[6], r, 640); PRE_LOAD(p[7], r, 704); }
    bf16 *QA, *KA, *VA, *QB, *KB, *VB, *SGA, *SGB; float* out; const float* rcos; const float* rsin; const float* rowsum;
    __device__ __forceinline__ void operator()(EPI_ARGS) const {
        const int reg = un.pn >> 2;
        const bool smp = un.pm >= MP / 256;
        const int row0 = un.pm * 256 + wr * 64 + fr;
        float rs[2][4];
#pragma unroll
        for (int ai = 0; ai < 2; ++ai)
#pragma unroll
            for (int m = 0; m < 4; ++m) rs[ai][m] = SCALE ? __builtin_amdgcn_rsqf(pre[ai * 4 + m] * (1.0f / DM) + EPS) : 1.0f;
        if (reg < 2) {
            const int cl = 64 * (4 * (un.pn & 3) + wc) + 8 * fq;
#pragma unroll
            for (int ai = 0; ai < 2; ++ai) {
                f32x4 cs[4][2][2];
#pragma unroll
                for (int m = 0; m < 4; ++m) { const int row = row0 + ai * 128 + m * 16; const int pos = smp ? 2048 + ((row - MP) & 63) : (row & 4095);
#pragma unroll
                    for (int n = 0; n < 2; ++n) { cs[m][n][0] = *(const f32x4*)(rcos + pos * 32 + 8 * fq + 4 * n); cs[m][n][1] = *(const f32x4*)(rsin + pos * 32 + 8 * fq + 4 * n); } }
                asm volatile("" :: "v"(cs[0][0][0]), "v"(cs[0][0][1]), "v"(cs[0][1][0]), "v"(cs[0][1][1]), "v"(cs[1][0][0]), "v"(cs[1][0][1]), "v"(cs[1][1][0]), "v"(cs[1][1][1]),
                                  "v"(cs[2][0][0]), "v"(cs[2][0][1]), "v"(cs[2][1][0]), "v"(cs[2][1][1]), "v"(cs[3][0][0]), "v"(cs[3][0][1]), "v"(cs[3][1][0]), "v"(cs[3][1][1]) : "memory");
#pragma unroll
                for (int m = 0; m < 4; ++m) {
                    const int row = row0 + ai * 128 + m * 16;
                    f32x4 o1[2], o2[2];
#pragma unroll
                    for (int n = 0; n < 2; ++n) {
                        const f32x4 c = cs[m][n][0], s = cs[m][n][1];
                        const f32x4 x1 = acc[ai][0][m][n] * rs[ai][m], x2 = acc[ai][1][m][n] * rs[ai][m];
                        o1[n] = x1 * c - x2 * s; o2[n] = x2 * c + x1 * s;
                        if (reg == 0) { o1[n] = o1[n] * QS_A; o2[n] = o2[n] * QS_A; }
                    }
                    v4u w1, w2; w1.x = cvt_pk_bf16(o1[0][0], o1[0][1]); w1.y = cvt_pk_bf16(o1[0][2], o1[0][3]); w1.z = cvt_pk_bf16(o1[1][0], o1[1][1]); w1.w = cvt_pk_bf16(o1[1][2], o1[1][3]);
                    w2.x = cvt_pk_bf16(o2[0][0], o2[0][1]); w2.y = cvt_pk_bf16(o2[0][2], o2[0][3]); w2.z = cvt_pk_bf16(o2[1][0], o2[1][1]); w2.w = cvt_pk_bf16(o2[1][2], o2[1][3]);
                    bf16* qk = (reg == 0 ? QA : KA) + (size_t)row * 1024 + cl;
                    *(v4u*)qk = w1; *(v4u*)(qk + 32) = w2;
                    if (reg == 1) {
                        float* ob = (smp ? out + OFF_AKS + (size_t)(row - MP) * 1024 : out + OFF_AKP + (size_t)row * 1024) + cl;
                        __builtin_nontemporal_store(o1[0], (f32x4*)ob); __builtin_nontemporal_store(o1[1], (f32x4*)(ob + 4));
                        __builtin_nontemporal_store(o2[0], (f32x4*)(ob + 32)); __builtin_nontemporal_store(o2[1], (f32x4*)(ob + 36));
                    }
                }
            }
        } else {
            const int rstart = reg < 6 ? reg * 1024 : (reg < 8 ? 6144 : 8192);
            const int cl0 = un.pn * 256 - rstart + wc * 32 + 8 * fq;
            const bool band = smp || ((un.pm & 15) >= 14);
#pragma unroll
            for (int ai = 0; ai < 2; ++ai)
#pragma unroll
                for (int m = 0; m < 4; ++m) {
                    const int row = row0 + ai * 128 + m * 16;
                    size_t brow;
                    if (smp) { const int rr = row - MP; brow = (size_t)(rr >> 6) * 512 + 448 + (rr & 63); }
                    else { const int bb = row >> 12; brow = (size_t)bb * 512 + ((row & 4095) - 3584); }
#pragma unroll
                    for (int bj = 0; bj < 2; ++bj) {
                        const int cl = cl0 + bj * 128;
                        f32x4 v0 = acc[ai][bj][m][0] * rs[ai][m], v1 = acc[ai][bj][m][1] * rs[ai][m];
                        if (reg == 2) {
                            float* ob = (smp ? out + OFF_AVS + (size_t)(row - MP) * 1024 : out + OFF_AVP + (size_t)row * 1024) + cl;
                            __builtin_nontemporal_store(v0, (f32x4*)ob); __builtin_nontemporal_store(v1, (f32x4*)(ob + 4));
                        } else if (reg == 4 || reg == 5) {
                            if (band) { float* ob = out + (reg == 4 ? (smp ? OFF_BKS : OFF_BKP) : (smp ? OFF_BVS : OFF_BVP)) + brow * 1024 + cl; __builtin_nontemporal_store(v0, (f32x4*)ob); __builtin_nontemporal_store(v1, (f32x4*)(ob + 4)); }
                        } else if (reg == 3) { v0 = v0 * QS_B; v1 = v1 * QS_B; }
                        else {
#pragma unroll
                            for (int j = 0; j < 4; ++j) { v0[j] = sigmoid_f(v0[j]); v1[j] = sigmoid_f(v1[j]); }
                        }
                        v4u w; w.x = cvt_pk_bf16(v0[0], v0[1]); w.y = cvt_pk_bf16(v0[2], v0[3]); w.z = cvt_pk_bf16(v1[0], v1[1]); w.w = cvt_pk_bf16(v1[2], v1[3]);
                        bf16* dst;
                        if (reg < 6) dst = (reg == 2 ? VA : reg == 3 ? QB : reg == 4 ? KB : VB) + (size_t)row * 1024 + cl;
                        else dst = (reg < 8 ? SGA : SGB) + (size_t)row * DM + cl;
                        *(v4u*)dst = w;
                    }
                }
        }
    }
};
struct EpiMerge {
    static constexpr int EPI_ID = 3;
    static constexpr bool DEFER = false;
    static constexpr int NVM = 32;
    static constexpr bool PERM = true, AFTER_DRAIN = false, HAS_MID = true, HAS_PRE = false; static constexpr int KMID = 16;
    const bf16* SGA; const bf16* SGB; bf16* O;
    __device__ __forceinline__ void mid(pg8::f32x4 (&acc)[2][2][4][2], const pg8::Unit& un, int wr, int wc, int fr, int fq) const {
        int row0 = un.pm * 256 + wr * 64 + fr, col0 = un.pn * 256 + wc * 32 + 8 * fq;
        asm volatile("" : "+v"(row0), "+v"(col0));
#pragma unroll
        for (int ai = 0; ai < 2; ++ai) {
            v4u a[8], b[8];
#pragma unroll
            for (int e = 0; e < 8; ++e) { const size_t off = (size_t)(row0 + ai * 128 + (e >> 1) * 16) * DM + col0 + (e & 1) * 128; a[e] = *(const v4u*)(SGA + off); b[e] = *(const v4u*)(SGB + off); }
            asm volatile("" :: "v"(a[0]), "v"(a[1]), "v"(a[2]), "v"(a[3]), "v"(a[4]), "v"(a[5]), "v"(a[6]), "v"(a[7]), "v"(b[0]), "v"(b[1]), "v"(b[2]), "v"(b[3]), "v"(b[4]), "v"(b[5]), "v"(b[6]), "v"(b[7]) : "memory");
#pragma unroll
            for (int e = 0; e < 8; ++e) { const int m = e >> 1, bj = e & 1;
                f32x4 r0, r1;
                r0[0] = bf_lo(a[e].x) * __builtin_amdgcn_rcpf(bf_lo(b[e].x)); r0[1] = bf_hi(a[e].x) * __builtin_amdgcn_rcpf(bf_hi(b[e].x));
                r0[2] = bf_lo(a[e].y) * __builtin_amdgcn_rcpf(bf_lo(b[e].y)); r0[3] = bf_hi(a[e].y) * __builtin_amdgcn_rcpf(bf_hi(b[e].y));
                r1[0] = bf_lo(a[e].z) * __builtin_amdgcn_rcpf(bf_lo(b[e].z)); r1[1] = bf_hi(a[e].z) * __builtin_amdgcn_rcpf(bf_hi(b[e].z));
                r1[2] = bf_lo(a[e].w) * __builtin_amdgcn_rcpf(bf_lo(b[e].w)); r1[3] = bf_hi(a[e].w) * __builtin_amdgcn_rcpf(bf_hi(b[e].w));
                acc[ai][bj][m][0] = acc[ai][bj][m][0] * r0; acc[ai][bj][m][1] = acc[ai][bj][m][1] * r1; }
        }
    }
    __device__ __forceinline__ void operator()(EPI_ARGS) const {
        const int row0 = un.pm * 256 + wr * 64 + fr, col0 = un.pn * 256 + wc * 32 + 8 * fq;
        v4u b[16];
#pragma unroll
        for (int e = 0; e < 16; ++e) b[e] = *(const v4u*)(SGB + (size_t)(row0 + (e >> 3) * 128 + ((e >> 1) & 3) * 16) * DM + col0 + (e & 1) * 128);
        asm volatile("" :: "v"(b[0]), "v"(b[1]), "v"(b[2]), "v"(b[3]), "v"(b[4]), "v"(b[5]), "v"(b[6]), "v"(b[7]), "v"(b[8]), "v"(b[9]), "v"(b[10]), "v"(b[11]), "v"(b[12]), "v"(b[13]), "v"(b[14]), "v"(b[15]) : "memory");
#pragma unroll
        for (int e = 0; e < 16; ++e) { const int ai = e >> 3, m = (e >> 1) & 3, bj = e & 1;
            const size_t off = (size_t)(row0 + ai * 128 + m * 16) * DM + col0 + bj * 128;
            const f32x4 v0 = acc[ai][bj][m][0], v1 = acc[ai][bj][m][1];
            v4u w; w.x = cvt_pk_bf16(v0[0] * bf_lo(b[e].x), v0[1] * bf_hi(b[e].x)); w.y = cvt_pk_bf16(v0[2] * bf_lo(b[e].y), v0[3] * bf_hi(b[e].y));
            w.z = cvt_pk_bf16(v1[0] * bf_lo(b[e].z), v1[1] * bf_hi(b[e].z)); w.w = cvt_pk_bf16(v1[2] * bf_lo(b[e].w), v1[3] * bf_hi(b[e].w));
            *(v4u*)(O + off) = w; }
    }
};
__device__ __forceinline__ int perm32inv(int c) { return 16 * ((c >> 2) & 1) + 4 * (c >> 3) + (c & 3); }
template <int MAP> __device__ __forceinline__ int rowmap(int n) {
    if constexpr (MAP == 1) return 256 * (n >> 7) + (n & 127);
    else if constexpr (MAP == 2) return 256 * (n >> 7) + 128 + (n & 127);
    else if constexpr (MAP == 3) { if (n >= 2048) return (n & ~31) + perm32inv(n & 31);
        const int l = n & 255, i = l & 31; return (n & ~255) + 128 * ((l >> 5) & 1) + 32 * (l >> 6) + 16 * ((i >> 2) & 1) + 4 * (i >> 3) + (i & 3); }
    else return n;
}
#ifdef TR_OLD
template <int MAP> __device__ __forceinline__ void tr_item(const float* W, int N, bf16* WT, int Kd, int koff, LAS float* scr, int item, int lane) {
    const int nblk = N / 32, kb = item / nblk, nb = item % nblk, k0 = 64 * kb, n0 = 32 * nb;
#pragma unroll 8
    for (int i = 0; i < 32; ++i) { const int kk = 2 * i + (lane >> 5); scr[kk * 33 + (lane & 31)] = W[(size_t)(k0 + kk) * N + n0 + (lane & 31)]; }
    LDS_WAIT(); asm volatile("" ::: "memory");
    const int c = lane & 7;
#pragma unroll
    for (int j = 0; j < 4; ++j) { const int n = (lane >> 3) + 8 * j; const LAS float* s = scr + (8 * c) * 33 + n;
        v4u o; o.x = pk2(s[0 * 33], s[1 * 33]); o.y = pk2(s[2 * 33], s[3 * 33]); o.z = pk2(s[4 * 33], s[5 * 33]); o.w = pk2(s[6 * 33], s[7 * 33]);
        *(GAS v4u*)(WT + (size_t)rowmap<MAP>(n0 + n) * Kd + koff + k0 + 8 * c) = o; }
    LDS_WAIT(); asm volatile("" ::: "memory");
}
#else
template <int MAP> __device__ __forceinline__ void tr_item(const float* W, int N, bf16* WT, int Kd, int koff, LAS float* scr, int item, int lane, const float* g = nullptr) {
    const int nblk = N / 32, kb = item / nblk, nb = item % nblk, k0 = 64 * kb, n0 = 32 * nb;
    const int kr = lane >> 3, nq = lane & 7;
    f32x4 v[8];
#pragma unroll
    for (int i = 0; i < 8; ++i) v[i] = __builtin_nontemporal_load((const GAS f32x4*)(W + (size_t)(k0 + 8 * i + kr) * N + n0 + 4 * nq));
#pragma unroll
    for (int i = 0; i < 8; ++i) { LAS float* d = scr + (8 * i + kr) * 33 + 4 * nq; d[0] = v[i].x; d[1] = v[i].y; d[2] = v[i].z; d[3] = v[i].w; }
    LDS_WAIT(); asm volatile("" ::: "memory");
    const int c = lane >> 3, n8 = lane & 7;
    f32x4 ga = (f32x4){1.f, 1.f, 1.f, 1.f}, gb = ga; if (g) { ga = *(const f32x4*)(g + k0 + 8 * c); gb = *(const f32x4*)(g + k0 + 8 * c + 4); }
#pragma unroll
    for (int j = 0; j < 4; ++j) { const int n = n8 + 8 * j; const LAS float* s = scr + (8 * c) * 33 + n;
        v4u o; o.x = pk2(s[0 * 33] * ga[0], s[1 * 33] * ga[1]); o.y = pk2(s[2 * 33] * ga[2], s[3 * 33] * ga[3]); o.z = pk2(s[4 * 33] * gb[0], s[5 * 33] * gb[1]); o.w = pk2(s[6 * 33] * gb[2], s[7 * 33] * gb[3]);
        *(GAS v4u*)(WT + (size_t)rowmap<MAP>(n0 + n) * Kd + koff + k0 + 8 * c) = o; }
    LDS_WAIT(); asm volatile("" ::: "memory");
}
#endif
struct TrDesc { const float* W; bf16* WT; const float* g; int N, Kd, koff, map, it; };
__device__ __forceinline__ int rowmap_rt(int map, int n) { return map == 1 ? rowmap<1>(n) : map == 2 ? rowmap<2>(n) : map == 3 ? rowmap<3>(n) : n; }
__device__ __forceinline__ TrDesc tr_desc(int j, int gw, const float* const* in, unsigned char* ws) {
    TrDesc d; d.koff = 0; d.map = 0; d.g = nullptr;
    if (j < 12) { const int q = j & 3, w = j >> 2; d.W = in[w == 0 ? 22 : w == 1 ? 23 : 24]; d.WT = (bf16*)(ws + (w == 2 ? WS_W2D : WS_W2)); d.N = w == 2 ? DM : FF; d.Kd = w == 2 ? FF : DM; d.map = w == 2 ? 0 : w + 1; d.it = gw + q * 2048; if (NORM_FOLD && w != 2) d.g = in[21]; }
    else if (j == 12) { d.W = in[20]; d.WT = (bf16*)(ws + WS_WOUT); d.N = DM; d.Kd = DM; d.it = gw; }
    else if (j == 13) { const bool second = gw >= 1024; d.W = in[second ? 19 : 18]; d.WT = (bf16*)(ws + WS_WBR); d.N = DM; d.Kd = DM; d.koff = second ? 1024 : 0; d.it = second ? gw - 1024 : gw; }
    else if (j < 19) { d.W = in[11]; d.WT = (bf16*)(ws + WS_WIN); d.N = NIN; d.Kd = DM; d.map = 3; d.it = gw + (j - 14) * 2048; if (NORM_FOLD) d.g = in[10]; }
    else { const int jj = j - 19, q = jj & 3, w = jj >> 2; d.W = in[w == 0 ? 9 : w == 1 ? 7 : 8]; d.WT = (bf16*)(ws + (w == 0 ? WS_W1D : WS_W1)); d.N = w == 0 ? DM : FF; d.Kd = w == 0 ? FF : DM; d.map = w; d.it = gw + q * 2048; }
    return d;
}
#define TR_LOAD(v, d) do { const int nblk_ = (d).N / 32, k0_ = 64 * ((d).it / nblk_), n0_ = 32 * ((d).it % nblk_); \
        _Pragma("unroll") for (int i_ = 0; i_ < 8; ++i_) v[i_] = __builtin_nontemporal_load((const GAS f32x4*)((d).W + (size_t)(k0_ + 8 * i_ + kr) * (d).N + n0_ + 4 * nq)); } while (0)
#define TR_TO_LDS(v) do { _Pragma("unroll") for (int i_ = 0; i_ < 8; ++i_) { LAS float* d_ = scr + (8 * i_ + kr) * 33 + 4 * nq; d_[0] = v[i_].x; d_[1] = v[i_].y; d_[2] = v[i_].z; d_[3] = v[i_].w; } \
        LDS_WAIT(); asm volatile("" ::: "memory"); } while (0)
#define TR_G2(d, ga_, gb_) do { if ((d).g) { const int nblk_ = (d).N / 32, k0_ = 64 * ((d).it / nblk_); ga_ = *(const GAS f32x4*)((d).g + k0_ + 8 * c); gb_ = *(const GAS f32x4*)((d).g + k0_ + 8 * c + 4); } \
        else { ga_ = (f32x4){1.f, 1.f, 1.f, 1.f}; gb_ = ga_; } } while (0)
#define TR_G(d) TR_G2(d, ga_, gb_)
#define TR_OUT(d) TR_OUT2(d, ga_, gb_)
#define TR_OUT2(d, ga_, gb_) do { const int nblk_ = (d).N / 32, k0_ = 64 * ((d).it / nblk_), n0_ = 32 * ((d).it % nblk_); \
        _Pragma("unroll") for (int j_ = 0; j_ < 4; ++j_) { const int n_ = n8 + 8 * j_; const LAS float* s_ = scr + (8 * c) * 33 + n_; \
            v4u o_; o_.x = pk2(s_[0 * 33] * ga_[0], s_[1 * 33] * ga_[1]); o_.y = pk2(s_[2 * 33] * ga_[2], s_[3 * 33] * ga_[3]); o_.z = pk2(s_[4 * 33] * gb_[0], s_[5 * 33] * gb_[1]); o_.w = pk2(s_[6 * 33] * gb_[2], s_[7 * 33] * gb_[3]); \
            GAS bf16* p_ = (GAS bf16*)((d).WT + (size_t)rowmap_rt((d).map, n0_ + n_) * (d).Kd + (d).koff + k0_ + 8 * c); \
            asm volatile("global_store_dwordx4 %0, %1, off\n\ts_nop 1" :: "v"(p_), "v"(o_) : "memory"); }     \
        LDS_WAIT(); asm volatile("" ::: "memory"); } while (0)
__device__ __forceinline__ TrDesc tr_desc_ffn2(int id, const float* const* in, unsigned char* ws) {
    TrDesc d; d.koff = 0; d.g = nullptr;
    if (id < 8192) { d.W = in[22]; d.WT = (bf16*)(ws + WS_W2); d.N = FF; d.Kd = DM; d.map = 1; d.it = id; if (NORM_FOLD) d.g = in[21]; }
    else if (id < 16384) { d.W = in[23]; d.WT = (bf16*)(ws + WS_W2); d.N = FF; d.Kd = DM; d.map = 2; d.it = id - 8192; if (NORM_FOLD) d.g = in[21]; }
    else { d.W = in[24]; d.WT = (bf16*)(ws + WS_W2D); d.N = DM; d.Kd = FF; d.map = 0; d.it = id - 16384; }
    return d;
}
__device__ __forceinline__ void p0_convert_stream(const float* const* in, unsigned char* ws, LAS float* scr, int gw, int lane, int j0  ) {
    const int kr = lane >> 3, nq = lane & 7, c = lane >> 3, n8 = lane & 7;
    f32x4 vA[8], vB[8], gA0, gA1, gB0, gB1, gN0, gN1;
    { const TrDesc d0 = tr_desc(j0, gw, in, ws), d1 = tr_desc(j0 + 1, gw, in, ws); TR_G2(d0, gA0, gA1); TR_LOAD(vA, d0); TR_G2(d1, gB0, gB1); TR_LOAD(vB, d1); }
    for (int j = j0; j < 30; j += 2) {
        { const TrDesc d = tr_desc(j, gw, in, ws), dn = tr_desc(j + 2, gw, in, ws); TR_TO_LDS(vA); TR_G2(dn, gN0, gN1); TR_LOAD(vA, dn); TR_OUT2(d, gA0, gA1); gA0 = gN0; gA1 = gN1; }
        { const TrDesc d = tr_desc(j + 1, gw, in, ws), dn = tr_desc(j + 3 < 31 ? j + 3 : 30, gw, in, ws); TR_TO_LDS(vB); TR_G2(dn, gN0, gN1); TR_LOAD(vB, dn); TR_OUT2(d, gB0, gB1); gB0 = gN0; gB1 = gN1; }
    }
    { const TrDesc d = tr_desc(30, gw, in, ws); TR_TO_LDS(vA); TR_OUT2(d, gA0, gA1); }
    asm volatile("s_waitcnt vmcnt(0)" ::: "memory");
}

#ifndef ATT_ROT
#define ATT_ROT 0
#endif
#ifndef ATT_SIMPLE0
#define ATT_SIMPLE0 0
#endif
#ifndef ATT_L3
#define ATT_L3 0
#endif
#ifndef CONV_L2
#define CONV_L2 0
#endif
namespace att {
typedef short bf16x8 __attribute__((ext_vector_type(8)));
typedef short s16x4 __attribute__((ext_vector_type(4)));
typedef float f32x16 __attribute__((ext_vector_type(16)));
typedef float f32x8 __attribute__((ext_vector_type(8)));
typedef unsigned u32x4 __attribute__((ext_vector_type(4)));
typedef unsigned u32x2l __attribute__((ext_vector_type(2)));
#define ATT_LAS __attribute__((address_space(3)))
#define KSWZ(row, colB) ((row) * 256 + ((colB) ^ (((row) & 7) << 4)))
#define SBAR() __builtin_amdgcn_sched_barrier(0)
constexpr float THR = 6.f;
__device__ __forceinline__ int crow(int r, int hi) { return (r & 3) + 8 * (r >> 2) + 4 * hi; }
__device__ __forceinline__ unsigned cvtpk(float lo, float hi) { unsigned r; asm volatile("v_cvt_pk_bf16_f32 %0, %1, %2" : "=v"(r) : "v"(lo), "v"(hi)); return r; }
template <typename TIn> struct Stage;
template <> struct Stage<unsigned short> { using T = bf16x8;
    __device__ static __forceinline__ T ld8(const unsigned short* p) { return *reinterpret_cast<const bf16x8*>(p); }
    __device__ static __forceinline__ bf16x8 tobf(T x) { return x; } };
template <> struct Stage<float> { using T = f32x8;
    __device__ static __forceinline__ T ld8(const float* p) { return *reinterpret_cast<const f32x8*>(p); }
    __device__ static __forceinline__ bf16x8 tobf(T x) { u32x4 w = {cvtpk(x[0], x[1]), cvtpk(x[2], x[3]), cvtpk(x[4], x[5]), cvtpk(x[6], x[7])}; return __builtin_bit_cast(bf16x8, w); } };

__device__ __forceinline__ void partialSM(f32x16& p0, f32x16& p1, float& m_reg, float& alpha) {
    float pmax = p0[0];
#pragma unroll
    for (int r = 1; r < 16; ++r) pmax = fmaxf(pmax, p0[r]);
#pragma unroll
    for (int r = 0; r < 16; ++r) pmax = fmaxf(pmax, p1[r]);
    { auto rr = __builtin_amdgcn_permlane32_swap(__float_as_uint(pmax), __float_as_uint(pmax), false, false); pmax = fmaxf(__uint_as_float(rr[0]), __uint_as_float(rr[1])); }
    float mn;
    if (__builtin_expect(__all(pmax - m_reg <= THR), 1)) { mn = m_reg; alpha = 1.f; }
    else { mn = fmaxf(m_reg, pmax); alpha = __builtin_amdgcn_exp2f(m_reg - mn); m_reg = mn; }
#pragma unroll
    for (int r = 0; r < 16; ++r) { p0[r] = p0[r] - mn; p1[r] = p1[r] - mn; }
#pragma unroll
    for (int r = 0; r < 16; ++r) p0[r] = __builtin_amdgcn_exp2f(p0[r]);
}
__device__ __forceinline__ void finishSM(f32x16& p0, f32x16& p1, float alpha, float& l_reg, bf16x8& pa0, bf16x8& pa1, bf16x8& pa2, bf16x8& pa3) {
#pragma unroll
    for (int r = 0; r < 16; ++r) p1[r] = __builtin_amdgcn_exp2f(p1[r]);
    float ps = 0;
#pragma unroll
    for (int r = 0; r < 16; ++r) ps += p0[r];
#pragma unroll
    for (int r = 0; r < 16; ++r) ps += p1[r];
    { auto rr = __builtin_amdgcn_permlane32_swap(__float_as_uint(ps), __float_as_uint(ps), false, false); ps = __uint_as_float(rr[0]) + __uint_as_float(rr[1]); }
    l_reg = l_reg * alpha + ps;
#define PK4(P, BASE, OUT) do { unsigned a0 = cvtpk(P[BASE + 0], P[BASE + 1]), a1 = cvtpk(P[BASE + 2], P[BASE + 3]);   \
    unsigned b0 = cvtpk(P[BASE + 4], P[BASE + 5]), b1 = cvtpk(P[BASE + 6], P[BASE + 7]);                              \
    auto r0 = __builtin_amdgcn_permlane32_swap(a0, b0, false, false); auto r1 = __builtin_amdgcn_permlane32_swap(a1, b1, false, false); \
    u32x4 w = {r0[0], r1[0], r0[1], r1[1]}; OUT = __builtin_bit_cast(bf16x8, w); } while (0)
    PK4(p0, 0, pa0); PK4(p0, 8, pa1); PK4(p1, 0, pa2); PK4(p1, 8, pa3);
#undef PK4
}
template <int NQ> __device__ __forceinline__ void qkt(f32x16& p0, f32x16& p1, const ATT_LAS char* Ks, const bf16x8* qr, int d0b, int r32, int hi) {
    p0 = f32x16{}; p1 = f32x16{};
#pragma unroll
    for (int d = 0; d < NQ; ++d) { const int cb = ((d0b + d) * 16 + hi * 8) * 2;
        const bf16x8 b0 = *reinterpret_cast<const ATT_LAS bf16x8*>(Ks + KSWZ(r32, cb));
        const bf16x8 b1 = *reinterpret_cast<const ATT_LAS bf16x8*>(Ks + KSWZ(32 + r32, cb));
        p0 = __builtin_amdgcn_mfma_f32_32x32x16_bf16(b0, qr[d], p0, 0, 0, 0);
        p1 = __builtin_amdgcn_mfma_f32_32x32x16_bf16(b1, qr[d], p1, 0, 0, 0); }
}
__device__ __forceinline__ int v_st(int k, int c) { const int kk = (k & ~0xC) | ((k & 4) << 1) | ((k & 8) >> 1); return ((kk >> 3) * 4 + (c >> 5)) * 512 + ((kk & 7) * 32 + (c & 31)) * 2; }
__device__ __forceinline__ int v_rd_base(int lane) { return ((lane & 3) << 3) | (((lane >> 2) & 3) << 6) | (((lane >> 4) & 1) << 5) | (((lane >> 5) & 1) << 8); }
constexpr int v_rd_off(int d0, int ks, int half) { return d0 * 512 + ks * 4096 + half * 2048; }
template <int OFF> __device__ __forceinline__ s16x4 tr_read(int vb) { s16x4 r; asm volatile("ds_read_b64_tr_b16 %0, %1 offset:%2" : "=&v"(r) : "v"(vb), "i"(OFF) : "memory"); return r; }
template <int KS> __device__ __forceinline__ void pv_step(f32x16* o, int vb, bf16x8 pa) {
    const s16x4 l0 = tr_read<v_rd_off(0, KS, 0)>(vb), h0 = tr_read<v_rd_off(0, KS, 1)>(vb), l1 = tr_read<v_rd_off(1, KS, 0)>(vb), h1 = tr_read<v_rd_off(1, KS, 1)>(vb);
    const s16x4 l2 = tr_read<v_rd_off(2, KS, 0)>(vb), h2 = tr_read<v_rd_off(2, KS, 1)>(vb), l3 = tr_read<v_rd_off(3, KS, 0)>(vb), h3 = tr_read<v_rd_off(3, KS, 1)>(vb);
    asm volatile("s_waitcnt lgkmcnt(0)" ::: "memory"); SBAR();
#define PKV(L, H) (bf16x8){L[0], L[1], L[2], L[3], H[0], H[1], H[2], H[3]}
    o[0] = __builtin_amdgcn_mfma_f32_32x32x16_bf16(pa, PKV(l0, h0), o[0], 0, 0, 0);
    o[1] = __builtin_amdgcn_mfma_f32_32x32x16_bf16(pa, PKV(l1, h1), o[1], 0, 0, 0);
    o[2] = __builtin_amdgcn_mfma_f32_32x32x16_bf16(pa, PKV(l2, h2), o[2], 0, 0, 0);
    o[3] = __builtin_amdgcn_mfma_f32_32x32x16_bf16(pa, PKV(l3, h3), o[3], 0, 0, 0);
#undef PKV
}
__device__ __forceinline__ void pv_d0(f32x16* o, int vb, bf16x8 pa0, bf16x8 pa1, bf16x8 pa2, bf16x8 pa3) {
    pv_step<0>(o, vb, pa0); pv_step<1>(o, vb, pa1); pv_step<2>(o, vb, pa2); pv_step<3>(o, vb, pa3);
}
struct AttnP { const bf16 *QA, *KA, *VA, *QB, *KB, *VB; bf16* OAB; const float *cak, *cav, *cbk, *cbv; float* out; const float* relb; const float* subln; float* dummy; float lam; const float* const* in; unsigned char* wsb; int conv_on; };

template <int KIND> __device__ __forceinline__ void attn_unit(const AttnP& P, const int u, ATT_LAS char* lds) {
    constexpr bool IS_A = KIND < 2, IS_S = (KIND & 1) != 0;
    constexpr int NQ = IS_A ? 4 : 8, SDEPTH = (KIND == 0 && !ATT_SIMPLE0) ? 2 : 1;
    using TS = typename std::conditional<IS_S, float, unsigned short>::type;
    using St = Stage<TS>;
    const int tid = threadIdx.x, wid = __builtin_amdgcn_readfirstlane(tid >> 6), lane = tid & 63, r32 = lane & 31, hi = lane >> 5;
    ATT_LAS char* V_lds = lds; ATT_LAS char* K_lds = lds + 32768;
    ATT_LAS float* wsc = (ATT_LAS float*)(lds + 65536) + wid * 64; ATT_LAS float* li_l = wsc; ATT_LAS float* al_l = wsc + 32;
    ATT_LAS float* tab = (ATT_LAS float*)(lds + 65536 + 2048);
    int h, NT, tsplit, map = 0, pslot = 0, cw = 0, kc0 = 0, qrow; bool active = true, lastmask = false;
    const bf16* Qw; const TS *Kt0, *Kt1, *Vt0, *Vt1;
    float* okb = nullptr; float* ovb = nullptr;
    if constexpr (KIND == 0) {
        const int qt = u & 31, b = u >> 8; h = (u >> 5) & 7; map = wid >> 2; pslot = wid & 3;
        qrow = b * 4096 + qt * 128 + pslot * 32; Qw = P.QA + (size_t)qrow * 1024 + h * 128 + map * 64;
        Kt0 = Kt1 = (const TS*)(P.KA + (size_t)b * 4096 * 1024 + h * 128); Vt0 = Vt1 = (const TS*)(P.VA + (size_t)b * 4096 * 1024 + h * 128);
        NT = 2 * qt + 2; tsplit = NT; lastmask = pslot < 2;
    } else if constexpr (KIND == 1) {
        const int b = u >> 3; h = u & 7; active = wid < 4; map = (wid >> 1) & 1; pslot = wid & 1;
        qrow = MP + b * 64 + pslot * 32; Qw = P.QA + (size_t)qrow * 1024 + h * 128 + map * 64;
        Kt0 = (const TS*)(P.cak + ((size_t)b * 2048 * 8 + h) * 128); Vt0 = (const TS*)(P.cav + ((size_t)b * 2048 * 8 + h) * 128);
        Kt1 = (const TS*)(P.out + OFF_AKS + ((size_t)b * 64 * 8 + h) * 128); Vt1 = (const TS*)(P.out + OFF_AVS + ((size_t)b * 64 * 8 + h) * 128);
        NT = 34; tsplit = 32;
    } else if constexpr (KIND == 2) {
        const int qg = u & 15, b = u >> 7; h = (u >> 4) & 7; const int c0 = 4 * qg; cw = c0 + (wid >> 1);
        qrow = b * 4096 + cw * 64 + (wid & 1) * 32; Qw = P.QB + (size_t)qrow * 1024 + h * 128;
        kc0 = c0 > 8 ? c0 - 8 : 0; NT = c0 + 4 - kc0; tsplit = NT;
        Kt0 = Kt1 = (const TS*)(P.KB + ((size_t)b * 4096 + kc0 * 64) * 1024 + h * 128); Vt0 = Vt1 = (const TS*)(P.VB + ((size_t)b * 4096 + kc0 * 64) * 1024 + h * 128);
    } else {
        const int b = u >> 3; h = u & 7; active = wid < 2; cw = 8;
        qrow = MP + b * 64 + (wid & 1) * 32; Qw = P.QB + (size_t)qrow * 1024 + h * 128;
        Kt0 = (const TS*)(P.cbk + ((size_t)b * 512 * 8 + h) * 128); Vt0 = (const TS*)(P.cbv + ((size_t)b * 512 * 8 + h) * 128);
        Kt1 = (const TS*)(P.out + OFF_BKS + (((size_t)b * 512 + 448) * 8 + h) * 128); Vt1 = (const TS*)(P.out + OFF_BVS + (((size_t)b * 512 + 448) * 8 + h) * 128);
        okb = P.out + OFF_BKS + ((size_t)b * 512 * 8 + h) * 128; ovb = P.out + OFF_BVS + ((size_t)b * 512 * 8 + h) * 128;
        NT = 10; tsplit = 8;
    }
    const int d0b = IS_A ? 4 * map : 0;
    const int qi = 32 * (wid & 1) + r32;
    float c256 = 0.f;
    if constexpr (!IS_A) { if (tid < 257) tab[tid] = P.relb[h * 257 + tid] * LOG2E; c256 = P.relb[h * 257 + 256] * LOG2E; }
    float m_reg = -1e30f, l_reg = 0.f; f32x16 o[4]; bf16x8 qr[NQ];
    if constexpr (!IS_S) { o[0] = f32x16{}; o[1] = f32x16{}; o[2] = f32x16{}; o[3] = f32x16{}; }
    if constexpr (!IS_S) {
#pragma unroll
        for (int d = 0; d < NQ; ++d) qr[d] = *reinterpret_cast<const bf16x8*>(Qw + (size_t)r32 * 1024 + d * 16 + hi * 8);
    }
    const int sr = tid >> 4, sc = (tid & 15) * 8, vst0 = v_st(sr, sc), vst1 = v_st(32 + sr, sc);
    const int vb0 = (int)(unsigned)(uintptr_t)V_lds + v_rd_base(lane);
    struct { typename St::T vs0, vs1, ks0, ks1; } sr_[SDEPTH];
#define SLOAD(i, t) do { if (!IS_S || (t) <= tsplit) { const TS* kb_ = ((t) < tsplit) ? Kt0 + (size_t)(t) * 65536 : Kt1; const TS* vb_ = ((t) < tsplit) ? Vt0 + (size_t)(t) * 65536 : Vt1; \
        sr_[i].vs0 = St::ld8(vb_ + sr * 1024 + sc); sr_[i].vs1 = St::ld8(vb_ + (32 + sr) * 1024 + sc); \
        sr_[i].ks0 = St::ld8(kb_ + sr * 1024 + sc); sr_[i].ks1 = St::ld8(kb_ + (32 + sr) * 1024 + sc); } } while (0)
#define SWRITE(bi, i, t) do { \
        *(ATT_LAS bf16x8*)(V_lds + (bi) * 16384 + vst0) = St::tobf(sr_[i].vs0); *(ATT_LAS bf16x8*)(V_lds + (bi) * 16384 + vst1) = St::tobf(sr_[i].vs1); \
        *(ATT_LAS bf16x8*)(K_lds + (bi) * 16384 + KSWZ(sr, sc * 2)) = St::tobf(sr_[i].ks0); *(ATT_LAS bf16x8*)(K_lds + (bi) * 16384 + KSWZ(32 + sr, sc * 2)) = St::tobf(sr_[i].ks1); \
        if constexpr (KIND == 3) { if ((t) >= 1 && (t) <= 7) { const size_t o_ = (size_t)((t) - 1) * 65536 + sr * 1024 + sc; \
            *(typename St::T*)(okb + o_) = sr_[i].ks0; *(typename St::T*)(okb + o_ + 32 * 1024) = sr_[i].ks1; *(typename St::T*)(ovb + o_) = sr_[i].vs0; *(typename St::T*)(ovb + o_ + 32 * 1024) = sr_[i].vs1; } } } while (0)
#define SWAIT() do { if constexpr (SDEPTH == 2) asm volatile("s_waitcnt vmcnt(4)" ::: "memory"); } while (0)
#define RESC(a) do { if (__any((a) < 1.f)) { if (hi == 0) al_l[r32] = (a); asm volatile("s_waitcnt lgkmcnt(0)" ::: "memory"); \
        _Pragma("unroll") for (int d_ = 0; d_ < 4; ++d_) _Pragma("unroll") for (int r_ = 0; r_ < 16; ++r_) o[d_][r_] *= al_l[crow(r_, hi)]; } } while (0)
#define SCORE(P0_, P1_, bi, t) do { if (active) { bool val_ = true; int dc_ = 0; \
        if constexpr (KIND == 0) { if ((t) == NT - 1 && lastmask) val_ = false; } \
        if constexpr (KIND >= 2) { dc_ = cw - (kc0 + (t)); val_ = (dc_ >= 0 && dc_ <= 8); } \
        if (val_) { qkt<NQ>(P0_, P1_, K_lds + (bi) * 16384, qr, d0b, r32, hi); \
            if constexpr (KIND >= 2) { \
                if (dc_ >= 3) { _Pragma("unroll") for (int r_ = 0; r_ < 16; ++r_) { P0_[r_] += c256; P1_[r_] += c256; } } \
                else { const int base_ = 64 * dc_ + qi + 128; \
                    _Pragma("unroll") for (int r_ = 0; r_ < 16; ++r_) { int i0_ = base_ - crow(r_, hi); int i1_ = i0_ - 32; i0_ = i0_ > 256 ? 256 : i0_; i1_ = i1_ > 256 ? 256 : i1_; P0_[r_] += tab[i0_]; P1_[r_] += tab[i1_]; if ((r_ & 3) == 3) asm volatile("" ::: "memory"); } } } } \
        else { _Pragma("unroll") for (int r_ = 0; r_ < 16; ++r_) { P0_[r_] = -INFINITY; P1_[r_] = -INFINITY; } } } } while (0)
    f32x16 pA0, pA1; float alA = 1.f; bf16x8 pa0, pa1, pa2, pa3;
    if constexpr (IS_S) {
        const int ntl = tsplit + 1;
        if (wid >= 4) {
            int ltid = tid - 256; asm volatile("" : "+v"(ltid));
            const int lr = ltid >> 5, lc = (ltid & 31) * 4;
            struct LR { f32x4 k[8], v[8]; }; LR R0, R1;
#define LLOAD(R, t) do { const float* kb_ = ((t) < tsplit) ? (const float*)Kt0 + (size_t)(t) * 65536 : (const float*)Kt1; const float* vb_ = ((t) < tsplit) ? (const float*)Vt0 + (size_t)(t) * 65536 : (const float*)Vt1; \
            _Pragma("unroll") for (int i_ = 0; i_ < 8; ++i_) { R.k[i_] = *reinterpret_cast<const f32x4*>(kb_ + (lr + 8 * i_) * 1024 + lc); R.v[i_] = *reinterpret_cast<const f32x4*>(vb_ + (lr + 8 * i_) * 1024 + lc); } } while (0)
#define LWRITE(R, bi, t) do { _Pragma("unroll") for (int i_ = 0; i_ < 8; ++i_) { const int row_ = lr + 8 * i_; \
                u32x2l wk_, wv_; wk_.x = cvtpk(R.k[i_][0], R.k[i_][1]); wk_.y = cvtpk(R.k[i_][2], R.k[i_][3]); wv_.x = cvtpk(R.v[i_][0], R.v[i_][1]); wv_.y = cvtpk(R.v[i_][2], R.v[i_][3]); \
                *(ATT_LAS u32x2l*)(K_lds + (bi) * 16384 + KSWZ(row_, lc * 2)) = wk_; *(ATT_LAS u32x2l*)(V_lds + (bi) * 16384 + v_st(row_, lc)) = wv_; \
                if constexpr (KIND == 3) { float* ok_ = (t) >= 1 ? okb + (size_t)((t) - 1) * 65536 : P.dummy; float* ov_ = (t) >= 1 ? ovb + (size_t)((t) - 1) * 65536 : P.dummy; \
                    __builtin_nontemporal_store(R.k[i_], (f32x4*)(ok_ + row_ * 1024 + lc)); __builtin_nontemporal_store(R.v[i_], (f32x4*)(ov_ + row_ * 1024 + lc)); } } \
            asm volatile("s_waitcnt lgkmcnt(0)" ::: "memory"); } while (0)
            const int lastt = ntl - 1;
            if constexpr (KIND == 1 && ATT_L3) {
                LR R2;
                LLOAD(R0, 0); LLOAD(R1, 1); LLOAD(R2, 2);
                int t = 0;
                for (; t + 2 < ntl; t += 3) {
                    LWRITE(R0, (t & 1), t); { const int tn = t + 3 < lastt ? t + 3 : lastt; LLOAD(R0, tn); } __builtin_amdgcn_s_barrier();
                    LWRITE(R1, ((t + 1) & 1), t + 1); { const int tn = t + 4 < lastt ? t + 4 : lastt; LLOAD(R1, tn); } __builtin_amdgcn_s_barrier();
                    LWRITE(R2, (t & 1), t + 2); { const int tn = t + 5 < lastt ? t + 5 : lastt; LLOAD(R2, tn); } __builtin_amdgcn_s_barrier();
                }
                if (t < ntl) { LWRITE(R0, (t & 1), t); __builtin_amdgcn_s_barrier(); ++t; }
                if (t < ntl) { LWRITE(R1, (t & 1), t); __builtin_amdgcn_s_barrier(); }
            } else {
                int t = 0;
                bool conv = false;
                if constexpr (KIND == 1) conv = P.conv_on != 0;
                if (conv) {
                    const int lwg = u * 4 + (wid - 4), kr = lane >> 3, nq = lane & 7, c = lane >> 3, n8 = lane & 7;
                    LAS float* scr = (LAS float*)(lds + 69632) + (wid - 4) * 2112;
                    f32x4 cv[8], ga_, gb_;
#if CONV_L2
                    LLOAD(R0, 0); LLOAD(R1, 1);
                    { const TrDesc d0 = tr_desc_ffn2(lwg, P.in, P.wsb); TR_LOAD(cv, d0); }
#define CONV_STEP(tt) do { const TrDesc d = tr_desc_ffn2((tt) * 1024 + lwg, P.in, P.wsb), dn = tr_desc_ffn2(((tt) + 1 < 24 ? (tt) + 1 : 23) * 1024 + lwg, P.in, P.wsb); TR_TO_LDS(cv); TR_G(d); TR_LOAD(cv, dn); TR_OUT(d); } while (0)
#pragma nounroll
                    for (; t < 24; t += 2) {
                        { const int lr0_ = lr, lc0_ = lc; { int lr = lr0_, lc = lc0_; asm volatile("" : "+v"(lr), "+v"(lc)); LWRITE(R0, 0, t); LLOAD(R0, t + 2); } } CONV_STEP(t); __builtin_amdgcn_s_barrier();
                        { const int lr0_ = lr, lc0_ = lc; { int lr = lr0_, lc = lc0_; asm volatile("" : "+v"(lr), "+v"(lc)); LWRITE(R1, 1, t + 1); LLOAD(R1, t + 3); } } CONV_STEP(t + 1); __builtin_amdgcn_s_barrier();
                    }
#undef CONV_STEP
#else
                    LLOAD(R0, 0);
                    f32x4 gn0, gn1;
                    { const TrDesc d0 = tr_desc_ffn2(lwg, P.in, P.wsb); TR_G2(d0, ga_, gb_); TR_LOAD(cv, d0); }
                    for (; t < 24; ++t) {
                        LWRITE(R0, (t & 1), t); LLOAD(R0, t + 1);
                        { const TrDesc d = tr_desc_ffn2(t * 1024 + lwg, P.in, P.wsb), dn = tr_desc_ffn2((t + 1 < 24 ? t + 1 : 23) * 1024 + lwg, P.in, P.wsb); TR_TO_LDS(cv); TR_G2(dn, gn0, gn1); TR_LOAD(cv, dn); TR_OUT2(d, ga_, gb_); ga_ = gn0; gb_ = gn1; }
                        __builtin_amdgcn_s_barrier();
                    }
                    LLOAD(R1, 25);
#endif
                } else { LLOAD(R0, 0); LLOAD(R1, 1); }
                for (; t + 1 < ntl; t += 2) {
                    LWRITE(R0, 0, t); { const int tn = t + 2 < lastt ? t + 2 : lastt; LLOAD(R0, tn); } __builtin_amdgcn_s_barrier();
                    LWRITE(R1, 1, t + 1); { const int tn = t + 3 < lastt ? t + 3 : lastt; LLOAD(R1, tn); } __builtin_amdgcn_s_barrier();
                }
                if (t < ntl) { LWRITE(R0, 0, t); __builtin_amdgcn_s_barrier(); }
            }
#undef LLOAD
#undef LWRITE
        } else {
            o[0] = f32x16{}; o[1] = f32x16{}; o[2] = f32x16{}; o[3] = f32x16{};
#pragma unroll
            for (int d = 0; d < NQ; ++d) qr[d] = *reinterpret_cast<const bf16x8*>(Qw + (size_t)r32 * 1024 + d * 16 + hi * 8);
            for (int t = 0; t < ntl; ++t) {
                __builtin_amdgcn_s_barrier();
                if (active) {
                    SCORE(pA0, pA1, (t & 1), t); partialSM(pA0, pA1, m_reg, alA); RESC(alA);
                    finishSM(pA0, pA1, alA, l_reg, pa0, pa1, pa2, pa3); SBAR();
                    pv_d0(o, vb0 + (t & 1) * 16384, pa0, pa1, pa2, pa3);
                }
            }
        }
    } else if constexpr (KIND != 0 || ATT_SIMPLE0) {
        const int ntl = NT;
        SLOAD(0, 0); SWRITE(0, 0, 0); __syncthreads();
        for (int t = 0; t < ntl; ++t) {
            if (t + 1 < ntl) SLOAD(0, t + 1);
            bool tile_on = active;
            if constexpr (KIND == 2) { const int dcw = cw - (kc0 + t); tile_on = (dcw >= 0 && dcw <= 8); }
            if (tile_on) {
                SCORE(pA0, pA1, (t & 1), t); partialSM(pA0, pA1, m_reg, alA); RESC(alA);
                finishSM(pA0, pA1, alA, l_reg, pa0, pa1, pa2, pa3); SBAR();
                pv_d0(o, vb0 + (t & 1) * 16384, pa0, pa1, pa2, pa3);
            }
            if (t + 1 < ntl) SWRITE(((t + 1) & 1), 0, t + 1);
            __syncthreads();
        }
    } else {
        f32x16 pB0, pB1; float alB = 1.f;
        constexpr int SE = 0, SO = SDEPTH - 1;
        SLOAD(SE, 0); SWRITE(0, SE, 0); __syncthreads();
        SCORE(pA0, pA1, 0, 0); if (active) partialSM(pA0, pA1, m_reg, alA);
        SLOAD(SO, 1); if constexpr (SDEPTH == 2) { if (2 < NT) SLOAD(SE, 2); }
        SWAIT(); SWRITE(1, SO, 1); __syncthreads();
#if ATT_ROT
        const bool rot = (map != 0);
        for (int j = 1; j + 1 < NT; j += 2) {
            SBAR();
            if (!rot) { SCORE(pB0, pB1, 1, j); SBAR(); finishSM(pA0, pA1, alA, l_reg, pa0, pa1, pa2, pa3); }
            else { finishSM(pA0, pA1, alA, l_reg, pa0, pa1, pa2, pa3); SBAR(); SCORE(pB0, pB1, 1, j); }
            SBAR(); SLOAD(SO, j + SDEPTH); SBAR();
            if (!rot) { pv_d0(o, vb0, pa0, pa1, pa2, pa3); SBAR(); partialSM(pB0, pB1, m_reg, alB); }
            else { partialSM(pB0, pB1, m_reg, alB); SBAR(); pv_d0(o, vb0, pa0, pa1, pa2, pa3); }
            __syncthreads(); SWAIT(); SWRITE(0, SE, j + 1);
            RESC(alB); __syncthreads();
            SBAR();
            if (!rot) { SCORE(pA0, pA1, 0, j + 1); SBAR(); finishSM(pB0, pB1, alB, l_reg, pa0, pa1, pa2, pa3); }
            else { finishSM(pB0, pB1, alB, l_reg, pa0, pa1, pa2, pa3); SBAR(); SCORE(pA0, pA1, 0, j + 1); }
            SBAR(); if (SDEPTH == 1 || j + 3 < NT) SLOAD(SE, j + 1 + SDEPTH); SBAR();
            if (!rot) { pv_d0(o, vb0 + 16384, pa0, pa1, pa2, pa3); SBAR(); partialSM(pA0, pA1, m_reg, alA); }
            else { partialSM(pA0, pA1, m_reg, alA); SBAR(); pv_d0(o, vb0 + 16384, pa0, pa1, pa2, pa3); }
            __syncthreads(); SWAIT(); SWRITE(1, SO, j + 2);
            RESC(alA); __syncthreads();
        }
#else
        for (int j = 1; j + 1 < NT; j += 2) {
            SBAR(); SCORE(pB0, pB1, 1, j);
            if (active) finishSM(pA0, pA1, alA, l_reg, pa0, pa1, pa2, pa3); SBAR();
            SLOAD(SO, j + SDEPTH); SBAR();
            if (active) { pv_d0(o, vb0, pa0, pa1, pa2, pa3); partialSM(pB0, pB1, m_reg, alB); }
            __syncthreads(); SWAIT(); SWRITE(0, SE, j + 1);
            if (active) RESC(alB); __syncthreads();
            SBAR(); SCORE(pA0, pA1, 0, j + 1);
            if (active) finishSM(pB0, pB1, alB, l_reg, pa0, pa1, pa2, pa3); SBAR();
            if (SDEPTH == 1 || j + 3 < NT) SLOAD(SE, j + 1 + SDEPTH); SBAR();
            if (active) { pv_d0(o, vb0 + 16384, pa0, pa1, pa2, pa3); partialSM(pA0, pA1, m_reg, alA); }
            __syncthreads(); SWAIT(); SWRITE(1, SO, j + 2);
            if (active) RESC(alA); __syncthreads();
        }
#endif
        if constexpr (!IS_S) { SBAR(); SCORE(pB0, pB1, 1, NT - 1); }
        if (active) finishSM(pA0, pA1, alA, l_reg, pa0, pa1, pa2, pa3); SBAR();
        if (active) pv_d0(o, vb0, pa0, pa1, pa2, pa3);
        if constexpr (!IS_S) {
            partialSM(pB0, pB1, m_reg, alB); RESC(alB);
            finishSM(pB0, pB1, alB, l_reg, pa0, pa1, pa2, pa3); SBAR();
            pv_d0(o, vb0 + 16384, pa0, pa1, pa2, pa3);
        }
    }
    if (active) {
        if (hi == 0) li_l[r32] = l_reg; asm volatile("s_waitcnt lgkmcnt(0)" ::: "memory");
#pragma unroll
        for (int r = 0; r < 16; ++r) { const float rl = __builtin_amdgcn_rcpf(li_l[crow(r, hi)]);
#pragma unroll
            for (int d0 = 0; d0 < 4; ++d0) o[d0][r] *= rl; }
    }
    if constexpr (IS_A) {
        __syncthreads();
        ATT_LAS float* xb = (ATT_LAS float*)lds + pslot * 4096 + lane;
        if (active && map == 1) {
#pragma unroll
            for (int d0 = 0; d0 < 4; ++d0)
#pragma unroll
                for (int r = 0; r < 16; ++r) xb[(d0 * 16 + r) * 64] = o[d0][r];
        }
        __syncthreads();
        if (active && map == 0) {
            const float lam = P.lam;
#pragma unroll
            for (int d0 = 0; d0 < 4; ++d0)
#pragma unroll
                for (int r = 0; r < 16; ++r) o[d0][r] -= lam * xb[(d0 * 16 + r) * 64];
            float g[4];
#pragma unroll
            for (int d0 = 0; d0 < 4; ++d0) g[d0] = P.subln[32 * d0 + r32] * (1.0f - LAM_INIT);
#pragma unroll
            for (int r = 0; r < 16; ++r) {
                float ss = o[0][r] * o[0][r] + o[1][r] * o[1][r] + o[2][r] * o[2][r] + o[3][r] * o[3][r];
                ss += __shfl_xor(ss, 1); ss += __shfl_xor(ss, 2); ss += __shfl_xor(ss, 4); ss += __shfl_xor(ss, 8); ss += __shfl_xor(ss, 16);
                const float rn = 1.0f / sqrtf(ss * (1.0f / 128.0f) + EPS);
                bf16* op = P.OAB + (size_t)(qrow + crow(r, hi)) * DM + h * 128 + r32;
#pragma unroll
                for (int d0 = 0; d0 < 4; ++d0) op[32 * d0] = (bf16)f2bf(o[d0][r] * rn * g[d0]);
            }
        }
    } else {
        if (active) {
#pragma unroll
            for (int r = 0; r < 16; ++r) { bf16* op = P.OAB + (size_t)(qrow + crow(r, hi)) * DM + 1024 + h * 128 + r32;
#pragma unroll
                for (int d0 = 0; d0 < 4; ++d0) op[32 * d0] = (bf16)f2bf(o[d0][r]); }
        }
    }
    __syncthreads();
#undef SLOAD
#undef SWRITE
#undef SWAIT
#undef RESC
#undef SCORE
}
#undef SBAR
}

#define NORM_LOAD(v, m_) do { \
        if constexpr (BF16IN) { const v4u* xr_ = (const v4u*)((m_) < MP ? (const bf16*)xlo + (size_t)(m_) * DM : (const bf16*)xhi + (size_t)((m_) - MP) * DM) + lane; \
            _Pragma("unroll") for (int jj_ = 0; jj_ < 4; ++jj_) { const v4u w_ = xr_[64 * jj_]; v[2 * jj_] = (f32x4){bf_lo(w_.x), bf_hi(w_.x), bf_lo(w_.y), bf_hi(w_.y)}; v[2 * jj_ + 1] = (f32x4){bf_lo(w_.z), bf_hi(w_.z), bf_lo(w_.w), bf_hi(w_.w)}; } } \
        else { const f32x4* xr_ = (const f32x4*)((m_) < MP ? (const float*)xlo + (size_t)(m_) * DM : (const float*)xhi + (size_t)((m_) - MP) * DM) + lane; \
            _Pragma("unroll") for (int j_ = 0; j_ < 8; ++j_) v[j_] = xr_[64 * j_]; } } while (0)
#define NORM_OUT(v, m_) do { float s_ = 0.f; \
        _Pragma("unroll") for (int j_ = 0; j_ < 8; ++j_) s_ += (v[j_].x * v[j_].x + v[j_].y * v[j_].y) + (v[j_].z * v[j_].z + v[j_].w * v[j_].w); \
        const float rstd_ = 1.0f / sqrtf(wave_sum(s_) * (1.0f / DM) + EPS); \
        if constexpr (F32OUT && BF16IN) { float* o_ = (float*)out + (size_t)(m_) * DM + 8 * lane; \
            _Pragma("unroll") for (int j_ = 0; j_ < 8; ++j_) __builtin_nontemporal_store(v[j_] * rstd_ * gv[j_], (f32x4*)(o_ + 512 * (j_ >> 1) + 4 * (j_ & 1))); } \
        else if constexpr (F32OUT) { f32x4* o_ = (f32x4*)((float*)out + (size_t)(m_) * DM) + lane; \
            _Pragma("unroll") for (int j_ = 0; j_ < 8; ++j_) __builtin_nontemporal_store(v[j_] * rstd_ * gv[j_], &o_[64 * j_]); } \
        else if constexpr (BF16IN) { v4u* o16_ = (v4u*)((bf16*)out + (size_t)(m_) * DM) + lane; \
            _Pragma("unroll") for (int jj_ = 0; jj_ < 4; ++jj_) { const f32x4 y0_ = v[2 * jj_] * rstd_ * gv[2 * jj_], y1_ = v[2 * jj_ + 1] * rstd_ * gv[2 * jj_ + 1]; \
                v4u w_; w_.x = pk2(y0_.x, y0_.y); w_.y = pk2(y0_.z, y0_.w); w_.z = pk2(y1_.x, y1_.y); w_.w = pk2(y1_.z, y1_.w); o16_[64 * jj_] = w_; } } \
        else { unsigned long long* o8_ = (unsigned long long*)((bf16*)out + (size_t)(m_) * DM) + lane; \
            _Pragma("unroll") for (int j_ = 0; j_ < 8; ++j_) { const f32x4 y_ = v[j_] * rstd_ * gv[j_]; o8_[64 * j_] = (unsigned long long)pk2(y_.x, y_.y) | ((unsigned long long)pk2(y_.z, y_.w) << 32); } } } while (0)
template <bool F32OUT, bool BF16IN> __device__ __forceinline__ void norm_rows(const void* __restrict__ xlo, const void* __restrict__ xhi, const float* __restrict__ g, void* __restrict__ out, int gw, int NGW, int lane) {
    f32x4 gv[8];
#pragma unroll
    for (int j = 0; j < 8; ++j) gv[j] = BF16IN ? *(const f32x4*)(g + 8 * lane + 512 * (j >> 1) + 4 * (j & 1)) : ((const f32x4*)g)[lane + 64 * j];
    if (gw >= M) return;
    f32x4 vA[8], vB[8];
    int mA = gw, mB = gw + NGW < M ? gw + NGW : gw;
    NORM_LOAD(vA, mA); NORM_LOAD(vB, mB);
    int m = gw;
    for (; m + NGW < M; m += 2 * NGW) {
        { const int cur = mA; NORM_OUT(vA, cur); mA = (cur + 2 * NGW < M) ? cur + 2 * NGW : cur; NORM_LOAD(vA, mA); }
        { const int cur = mB; NORM_OUT(vB, cur); mB = (cur + 2 * NGW < M) ? cur + 2 * NGW : cur; NORM_LOAD(vB, mB); }
    }
    if (m < M) { NORM_OUT(vA, mA); }
}
#undef NORM_LOAD
#undef NORM_OUT
__constant__ float ROPE_INV[32] = {
    1.000000000e+00f, 7.498942614e-01f, 5.623413324e-01f, 4.216965139e-01f, 3.162277639e-01f, 2.371373773e-01f, 1.778279394e-01f, 1.333521307e-01f,
    1.000000015e-01f, 7.498941571e-02f, 5.623413250e-02f, 4.216965288e-02f, 3.162277490e-02f, 2.371373773e-02f, 1.778279431e-02f, 1.333521493e-02f,
    9.999999776e-03f, 7.498941850e-03f, 5.623413250e-03f, 4.216964822e-03f, 3.162277630e-03f, 2.371373586e-03f, 1.778279431e-03f, 1.333521446e-03f,
    1.000000047e-03f, 7.498942432e-04f, 5.623413017e-04f, 4.216965172e-04f, 3.162277571e-04f, 2.371373703e-04f, 1.778279402e-04f, 1.333521504e-04f };

struct Args { const float* in[26]; float* out; unsigned char* ws; int ph_lo, ph_hi, li, pad; };
__global__ void __launch_bounds__(NWAVES * 64, 2) fwd_kernel(Args args) {
    extern __shared__ __attribute__((aligned(16))) unsigned char lds_raw[];
    LAS unsigned char* lds = (LAS unsigned char*)lds_raw;
    volatile LAS unsigned* MISC = (volatile LAS unsigned*)(lds + MISC_OFF);
    const int tid = threadIdx.x, lane = tid & 63, wave = __builtin_amdgcn_readfirstlane(tid >> 6);
    const int G = gridDim.x; int vcu; { const int bx = blockIdx.x; vcu = (G % 8 == 0) ? (bx % 8) * (G / 8) + bx / 8 : bx; }
    const int gw = vcu * NWAVES + wave, NGW = G * NWAVES;
    unsigned char* ws = args.ws;
    gu32* ctl = (gu32*)(ws + WS_CTL);
    for (int i = tid; i < (LDS_BYTES - LDSCTL_OFF) / 4; i += NWAVES * 64) ((LAS unsigned*)(lds + LDSCTL_OFF))[i] = 0u;
    __syncthreads();
    XcdBarrier bar; bar.bar = (unsigned*)(ctl + CW_BAR); bar.x = 0; bar.st = nullptr;
    if (N_LAUNCHES == 1) bar = xcd_barrier_post((unsigned*)(ctl + CW_BAR), MISC + 8);
#ifdef BAR_TWICE
#define GRID_BAR() do { if (N_LAUNCHES == 1) { xcd_barrier(bar); xcd_barrier(bar); } } while (0)
#else
#define GRID_BAR() do { if (N_LAUNCHES == 1) xcd_barrier(bar); } while (0)
#endif
    const int lo = args.ph_lo, hi = args.ph_hi;
#ifndef PHMASK
#define PHMASK 0xFFF
#endif
#define IN(k) ((((PHMASK) >> (k)) & 1) && lo <= (k) && (k) < hi)
#define BOTH(k) (IN(k) && IN((k) + 1))
#ifndef REPMASK
#define REPMASK 0
#endif
#if REPMASK == 0
#define REP(k)
#else
#define REP(k) _Pragma("unroll") for (int rep_ = 0; rep_ < 1 + (((REPMASK) >> (k)) & 1); ++rep_)
#endif
    constexpr int R5 = 1 + (((REPMASK) >> 5) & 1);
    const float* x_prompt = args.in[0]; const float* x_sample = args.in[1];
    bf16* W1 = (bf16*)(ws + WS_W1); bf16* W1D = (bf16*)(ws + WS_W1D); bf16* WIN = (bf16*)(ws + WS_WIN); bf16* WBR = (bf16*)(ws + WS_WBR); bf16* WOUT = (bf16*)(ws + WS_WOUT);
    bf16* W2 = (bf16*)(ws + WS_W2); bf16* W2D = (bf16*)(ws + WS_W2D);
    bf16* H = (bf16*)(ws + WS_H); bf16* ACT = (bf16*)(ws + WS_ACT); unsigned char* X1 = ws + WS_X1; unsigned char* X2 = ws + WS_X2; unsigned char* X3 = ws + WS_X1;
#define XHI(p) ((p) + (size_t)MP * DM * (RESID_BF16 ? 2 : 4))
    bf16* QA = (bf16*)(ws + WS_QA); bf16* KA = (bf16*)(ws + WS_KA); bf16* VA = (bf16*)(ws + WS_VA); bf16* QB = (bf16*)(ws + WS_QB); bf16* KB = (bf16*)(ws + WS_KB); bf16* VB = (bf16*)(ws + WS_VB);
    bf16* SGA = (bf16*)(ws + WS_SGA); bf16* SGB = (bf16*)(ws + WS_SGB); bf16* OAB = (bf16*)(ws + WS_OAB); bf16* MRG = (bf16*)(ws + WS_MRG);
    float* RCOS = (float*)(ws + WS_ROPE); float* RSIN = RCOS + 4096 * 32;
    float* RS_MIX = (float*)(ctl + CW_RS); float* RS_FFN2 = RS_MIX + M;
#ifndef RESID_BF16
#define RESID_BF16 1
#endif
static_assert(!NORM_FOLD || RESID_BF16, "NORM_FOLD feeds the bf16 residual stream to the next GEMM as its A operand");
#ifndef FINAL_FUSE
#define FINAL_FUSE 1
#endif
static_assert(!FINAL_FUSE || (N_LAUNCHES == 1 && RESID_BF16), "FINAL_FUSE: grid barrier inside the last GEMM epilogue, bf16 residual stream");
#ifndef X3_BF16
#define X3_BF16 0
#endif
#ifndef CONV_IN_ATTN
#define CONV_IN_ATTN 1
#endif
#ifndef GEMM_ALIGN
#define GEMM_ALIGN true
#endif
#ifndef GEMM_SP2
#define GEMM_SP2 true
#endif
#ifndef FUSE_NORM
#define FUSE_NORM 0
#endif
#define RUN_GEMM(EpiT, E_, A_, B_, N_, K_) do { pg8::Gemm g_{(const pg8::bf16_t*)(A_), (const pg8::bf16_t*)(B_), M, (N_), (K_)}; pg8::StaticOrder S_; S_.init(M, (N_), (K_), G, (int)blockIdx.x); \
        pg8::gemm_phase<EpiT, pg8::StaticOrder, GEMM_ALIGN, GEMM_SP2, false>(lds, g_, S_, E_); } while (0)
#define RUN_GEMM_SK(EpiT, E_, A_, B_, N_, K_, bank_) do { pg8::Gemm g_{(const pg8::bf16_t*)(A_), (const pg8::bf16_t*)(B_), M, (N_), (K_)}; pg8::SplitOrder S_; \
        S_.init(M, (N_), (K_), G, (int)blockIdx.x, (float*)(ws + WS_SLAB + (size_t)(bank_) * SLAB_BANK), (unsigned*)(ctl + CW_SK + (bank_) * SK_BANK), (unsigned*)(ctl + CW_TMO)); \
        pg8::gemm_phase<EpiT, pg8::SplitOrder, GEMM_ALIGN, GEMM_SP2, true>(lds, g_, S_, E_); } while (0)

    if (IN(0)) REP(0) {
        LAS float* scr = (LAS float*)(lds + wave * 16384);
        constexpr int I_FF = 32 * 256, I_D = 128 * 64, I_IN = 32 * 320, I_BR = 16 * 64, I_O = 32 * 64;
        constexpr int NITEMS = 2 * (2 * I_FF + I_D) + I_IN + 2 * I_BR + I_O;
        if (NGW == 2048) p0_convert_stream(args.in, ws, scr, gw, lane, CONV_IN_ATTN ? 12 : 0);
        else for (int it = gw; it < NITEMS; it += NGW) {
            int r = it;
            if (r < I_FF) { tr_item<1>(args.in[22], FF, W2, DM, 0, scr, r, lane, NORM_FOLD ? args.in[21] : nullptr); continue; } r -= I_FF;
            if (r < I_FF) { tr_item<2>(args.in[23], FF, W2, DM, 0, scr, r, lane, NORM_FOLD ? args.in[21] : nullptr); continue; } r -= I_FF;
            if (r < I_D) { tr_item<0>(args.in[24], DM, W2D, FF, 0, scr, r, lane); continue; } r -= I_D;
            if (r < I_O) { tr_item<0>(args.in[20], DM, WOUT, DM, 0, scr, r, lane); continue; } r -= I_O;
            if (r < I_BR) { tr_item<0>(args.in[18], DM, WBR, DM, 0, scr, r, lane); continue; } r -= I_BR;
            if (r < I_BR) { tr_item<0>(args.in[19], DM, WBR, DM, 1024, scr, r, lane); continue; } r -= I_BR;
            if (r < I_IN) { tr_item<3>(args.in[11], NIN, WIN, DM, 0, scr, r, lane, NORM_FOLD ? args.in[10] : nullptr); continue; } r -= I_IN;
            if (r < I_D) { tr_item<0>(args.in[9], DM, W1D, FF, 0, scr, r, lane); continue; } r -= I_D;
            if (r < I_FF) { tr_item<1>(args.in[7], FF, W1, DM, 0, scr, r, lane); continue; } r -= I_FF;
            tr_item<2>(args.in[8], FF, W1, DM, 0, scr, r, lane);
        }
        for (int e = vcu * (NWAVES * 64) + tid; e < 4096 * 32; e += G * NWAVES * 64) {
            const int pos = e >> 5, i = e & 31;
            const float ang = (float)pos * ROPE_INV[i];
            double rev = (double)ang * 0.15915494309189535; rev -= __builtin_rint(rev);
            const float fr = (float)rev;
            RCOS[e] = __builtin_amdgcn_cosf(fr); RSIN[e] = __builtin_amdgcn_sinf(fr);
        }
        norm_rows<false, false>(x_prompt, x_sample, args.in[6], H, gw, NGW, lane);
        if (BOTH(0)) GRID_BAR();
    }
    if (IN(1)) REP(1) { EpiSwiglu<false> E{ACT, nullptr}; RUN_GEMM(EpiSwiglu<false>, E, H, W1, 2 * FF, DM); if (BOTH(1)) GRID_BAR(); }
#if FUSE_NORM
    if (IN(2)) REP(2) { EpiResidNorm E{x_prompt, x_sample, X1, 0.5f, args.in[10], H, RS_MIX}; RUN_GEMM_SK(EpiResidNorm, E, ACT, W1D, DM, FF, 0); if (BOTH(2)) GRID_BAR(); }
#else
    if (IN(2)) REP(2) { typedef EpiResid<false, RESID_BF16 != 0, NORM_FOLD != 0> EP; EP E{x_prompt, x_sample, X1, 0.5f, RS_MIX}; RUN_GEMM_SK(EP, E, ACT, W1D, DM, FF, 0); if (BOTH(2)) GRID_BAR(); }
#endif
#if !FUSE_NORM
    if (!NORM_FOLD && IN(3)) REP(3) { norm_rows<false, RESID_BF16 != 0>(X1, XHI(X1), args.in[10], H, gw, NGW, lane); if (BOTH(3)) GRID_BAR(); }
#endif
    if (IN(4)) REP(4) { EpiWin<(FUSE_NORM || NORM_FOLD)> E{QA, KA, VA, QB, KB, VB, SGA, SGB, args.out, RCOS, RSIN, RS_MIX}; RUN_GEMM_SK(EpiWin<(FUSE_NORM || NORM_FOLD)>, E, (NORM_FOLD ? (const bf16*)X1 : H), WIN, NIN, DM, 1); if (BOTH(4)) GRID_BAR(); }
    if (IN(5)) {
        float lam;
        { const float s1 = wave_sum(args.in[12][lane] * args.in[13][lane]), s2 = wave_sum(args.in[14][lane] * args.in[15][lane]); lam = expf(s1) - expf(s2) + LAM_INIT; }
        const att::AttnP AP{QA, KA, VA, QB, KB, VB, OAB, args.in[2], args.in[3], args.in[4], args.in[5], args.out, args.in[17], args.in[16], (float*)(ws + WS_SLAB), lam, args.in, ws, (CONV_IN_ATTN && NGW == 2048) ? 1 : 0};
        ATT_LAS char* al = (ATT_LAS char*)lds;
#ifndef KMASK
#define KMASK 15
#endif
#ifndef REPK
#define REPK 0
#endif
#define RK(k) (1 + (((REPK) >> (k)) & 1))
#define SAMPLE_UNITS() do { if (KMASK & 2) for (int u = vcu; u < 256 * RK(1); u += G) att::attn_unit<1>(AP, u & 255, al); \
                            if (KMASK & 8) for (int u = vcu; u < 256 * RK(3); u += G) att::attn_unit<3>(AP, u & 255, al); } while (0)
        const bool sample_first = (vcu & 1) == 0;
        if (sample_first) SAMPLE_UNITS();
        if (KMASK & 1) for (int i = vcu; i < 512 * RK(0); i += G) { const int v = i & 255, s = v & 15, qt = ((i >> 8) & 1) ? 31 - s : s; att::attn_unit<0>(AP, (v >> 4) * 32 + qt, al); }
        if (KMASK & 4) for (int u = vcu; u < 256 * RK(2); u += G) att::attn_unit<2>(AP, u & 255, al);
        if (!sample_first) SAMPLE_UNITS();
#undef SAMPLE_UNITS
        if (BOTH(5)) GRID_BAR();
    }
    if (IN(6)) REP(6) { EpiMerge E{SGA, SGB, MRG}; RUN_GEMM_SK(EpiMerge, E, OAB, WBR, DM, DM, 2); if (BOTH(6)) GRID_BAR(); }
#if FUSE_NORM
    if (IN(7)) REP(7) { EpiResidNorm E{X1, X1 + (size_t)MP * DM, X2, 1.0f, args.in[21], H, RS_FFN2}; RUN_GEMM_SK(EpiResidNorm, E, MRG, WOUT, DM, DM, 3); if (BOTH(7)) GRID_BAR(); }
#else
    if (IN(7)) REP(7) { typedef EpiResid<RESID_BF16 != 0, RESID_BF16 != 0, NORM_FOLD != 0> EP; EP E{X1, XHI(X1), X2, 1.0f, RS_FFN2}; RUN_GEMM_SK(EP, E, MRG, WOUT, DM, DM, 3); if (BOTH(7)) GRID_BAR(); }
    if (!NORM_FOLD && IN(8)) REP(8) { norm_rows<false, RESID_BF16 != 0>(X2, XHI(X2), args.in[21], H, gw, NGW, lane); if (BOTH(8)) GRID_BAR(); }
#endif
    if (IN(9)) REP(9) { EpiSwiglu<(FUSE_NORM || NORM_FOLD)> E{ACT, RS_FFN2}; RUN_GEMM(EpiSwiglu<(FUSE_NORM || NORM_FOLD)>, E, (NORM_FOLD ? (const bf16*)X2 : H), W2, 2 * FF, DM); if (BOTH(9)) GRID_BAR(); }
#if FINAL_FUSE
    if (IN(10)) { EpiFinal E{(const bf16*)X2, (const bf16*)XHI(X2), (float*)X3, args.out, args.in[25], RS_FFN2 + M, 0.5f, bar}; RUN_GEMM_SK(EpiFinal, E, ACT, W2D, DM, FF, 4); }
#else
    if (IN(10)) REP(10) { typedef EpiResid<RESID_BF16 != 0, X3_BF16 != 0, false> EP; EP E{X2, XHI(X2), X3, 0.5f, nullptr}; RUN_GEMM_SK(EP, E, ACT, W2D, DM, FF, 4); if (BOTH(10)) GRID_BAR(); }
    if (IN(11)) REP(11) { norm_rows<true, X3_BF16 != 0>(X3, X3 + (size_t)MP * DM * (X3_BF16 ? 2 : 4), args.in[25], args.out, gw, NGW, lane); }
#endif
#undef IN
#undef BOTH
}

extern "C" void kernel_launch(void* const* d_in, const int* in_sizes, int n_in, void* d_out, int out_size, void* d_ws, size_t ws_size, hipStream_t stream) {
    static int grid = 0;
    if (grid == 0) {
        if (n_in != 26 || in_sizes[0] != MP * DM || in_sizes[1] != MS * DM || (size_t)out_size != OUT_ELEMS || ws_size < WS_END) {
            fprintf(stderr, "kernel_launch: shape mismatch: n_in %d in0 %d in1 %d out %d ws %zu (need >= %zu); nothing launched\n", n_in, n_in > 0 ? in_sizes[0] : -1, n_in > 1 ? in_sizes[1] : -1, out_size, ws_size, (size_t)WS_END); grid = -1; return; }
        int dev = 0, cus = 0, per_cu = 0;
        if (hipGetDevice(&dev) != hipSuccess || hipDeviceGetAttribute(&cus, hipDeviceAttributeMultiprocessorCount, dev) != hipSuccess) { fprintf(stderr, "kernel_launch: device query failed\n"); grid = -1; return; }
        if (hipFuncSetAttribute((const void*)fwd_kernel, hipFuncAttributeMaxDynamicSharedMemorySize, LDS_BYTES) != hipSuccess) { fprintf(stderr, "kernel_launch: hipFuncSetAttribute failed\n"); grid = -1; return; }
        if (hipOccupancyMaxActiveBlocksPerMultiprocessor(&per_cu, (const void*)fwd_kernel, NWAVES * 64, LDS_BYTES) != hipSuccess || per_cu < 1) { fprintf(stderr, "kernel_launch: occupancy query reports %d workgroups per CU; nothing launched\n", per_cu); (void)hipGetLastError(); grid = -1; return; }
        (void)hipGetLastError();
        grid = cus;
    }
    if (grid < 0) return;
    if (hipMemsetAsync((char*)d_ws + WS_CTL, 0, CTL_ZERO_BYTES, stream) != hipSuccess) { fprintf(stderr, "kernel_launch: memset failed\n"); return; }
    Args a{};
    for (int i = 0; i < 26; ++i) a.in[i] = (const float*)d_in[i];
    a.out = (float*)d_out; a.ws = (unsigned char*)d_ws;
    for (int li = 0; li < N_LAUNCHES; ++li) {
        a.ph_lo = (N_LAUNCHES == 1) ? 0 : li; a.ph_hi = (N_LAUNCHES == 1) ? N_PHASES : li + 1; a.li = li; a.pad = 0;
        hipLaunchKernelGGL(fwd_kernel, dim3(grid), dim3(NWAVES * 64), LDS_BYTES, stream, a);
        const hipError_t le = hipPeekAtLastError();
        if (le != hipSuccess) { fprintf(stderr, "kernel_launch: launch %d failed: %s\n", li, hipGetErrorName(le)); break; }
    }
}
```
